# Optimizing an MI355X kernel written in HIP

```python
import jax, jax.numpy as jnp
from jax import lax
import numpy as np

D_MODEL = 4096
BATCH = 4
SEQ = 4096
DEPTH = 1

CHUNK = 64
Q_BLOCK = 128
HEAD_DIM = 128
ROPE_THETA = 10000.0
EPS = 1e-6
N_HEADS_A = 16
N_KV_A = 2
Q_RANK = 1024
N_IDX_HEADS = 32
IDX_DIM = 64
IDX_ROPE_DIM = 32
INDEX_TOPK = 256
N_HEADS_B = 16
D_FF = ((8 * D_MODEL + 3 * 256 - 1) // (3 * 256)) * 256
PLE_DIM = 256

W_A = N_HEADS_A * HEAD_DIM
KV_A_W = N_KV_A * HEAD_DIM
W_B = N_HEADS_B * HEAD_DIM
SPLIT_SIZES = (Q_RANK, KV_A_W, KV_A_W, IDX_DIM, N_IDX_HEADS, W_B, W_B, W_B, N_HEADS_B, D_MODEL, D_MODEL)
IN_WIDTH = sum(SPLIT_SIZES)

kernel_name = "hybrid_dsa_fox_gated_block"


def _split_offsets():
    offs, acc = [], 0
    for s in SPLIT_SIZES[:-1]:
        acc += s
        offs.append(acc)
    return offs


def rms_norm(x, g):
    xf = x.astype(jnp.float32)
    y = xf * lax.rsqrt(jnp.mean(xf * xf, axis=-1, keepdims=True) + EPS)
    return (y * g.astype(jnp.float32)).astype(x.dtype)


def layer_norm(x, g, b):
    xf = x.astype(jnp.float32)
    mu = jnp.mean(xf, axis=-1, keepdims=True)
    var = jnp.mean(jnp.square(xf - mu), axis=-1, keepdims=True)
    y = (xf - mu) * lax.rsqrt(var + EPS) * g.astype(jnp.float32) + b.astype(jnp.float32)
    return y.astype(x.dtype)


def rope(x, pos, rot_dim):
    half = rot_dim // 2
    inv_freq = jnp.power(ROPE_THETA, -jnp.arange(half, dtype=jnp.float32) * (2.0 / rot_dim))
    ang = pos.astype(jnp.float32)[..., None] * inv_freq
    cos = jnp.cos(ang)[:, :, None, :]
    sin = jnp.sin(ang)[:, :, None, :]
    xf = x.astype(jnp.float32)
    x1 = xf[..., :half]
    x2 = xf[..., half:rot_dim]
    out = jnp.concatenate([x1 * cos - x2 * sin, x2 * cos + x1 * sin, xf[..., rot_dim:]], axis=-1)
    return out.astype(x.dtype)


def _to_blocks(a, n_blocks):
    b = a.shape[0]
    return jnp.moveaxis(a.reshape((b, n_blocks, Q_BLOCK) + a.shape[2:]), 1, 0)


def dsa_sparse_attention(q, k, v, q_idx, k_idx, w_idx, top_k):
    B, S, H, Dh = q.shape
    nb = S // Q_BLOCK
    G = H // N_KV_A
    scale = Dh ** -0.5
    key_pos = jnp.arange(S)

    def block(args):
        qb, qib, wb, start = args
        t = start + jnp.arange(Q_BLOCK)
        visible_end = (t // CHUNK + 1) * CHUNK
        s_idx = jnp.einsum('bqhd,bkd->bqhk', qib, k_idx).astype(jnp.float32)
        index = jnp.einsum('bqhk,bqh->bqk', jax.nn.relu(s_idx), wb.astype(jnp.float32))
        admissible = key_pos[None, :] < visible_end[:, None]
        index = jnp.where(admissible[None], index, -jnp.inf)
        _, sel = lax.top_k(index, top_k)
        valid = sel < visible_end[None, :, None]
        k_sel = jax.vmap(lambda kb, ib: kb[ib])(k, sel)
        v_sel = jax.vmap(lambda vb, ib: vb[ib])(v, sel)
        qg = qb.reshape(B, Q_BLOCK, N_KV_A, G, Dh)
        logits = jnp.einsum('bqgrd,bqkgd->bqgrk', qg, k_sel).astype(jnp.float32) * scale
        logits = jnp.where(valid[:, :, None, None, :], logits, -jnp.inf)
        probs = jax.nn.softmax(logits, axis=-1).astype(v.dtype)
        o = jnp.einsum('bqgrk,bqkgd->bqgrd', probs, v_sel)
        return o.reshape(B, Q_BLOCK, H * Dh)

    starts = jnp.arange(nb) * Q_BLOCK
    out = lax.map(block, (_to_blocks(q, nb), _to_blocks(q_idx, nb), _to_blocks(w_idx, nb), starts))
    return jnp.moveaxis(out, 0, 1).reshape(B, S, H * Dh)


def forgetting_attention(q, k, v, log_f):
    B, S, H, Dh = q.shape
    nb = S // Q_BLOCK
    scale = Dh ** -0.5
    key_pos = jnp.arange(S)
    F = jnp.cumsum(log_f, axis=1)
    F_k = jnp.transpose(F, (0, 2, 1))

    def block(args):
        qb, Fq, start = args
        t = start + jnp.arange(Q_BLOCK)
        causal = key_pos[None, :] <= t[:, None]
        decay = jnp.transpose(Fq, (0, 2, 1))[..., None] - F_k[:, :, None, :]
        logits = jnp.einsum('bqhd,bkhd->bhqk', qb, k).astype(jnp.float32) * scale + decay
        logits = jnp.where(causal[None, None], logits, -jnp.inf)
        probs = jax.nn.softmax(logits, axis=-1).astype(v.dtype)
        o = jnp.einsum('bhqk,bkhd->bqhd', probs, v)
        return o.reshape(B, Q_BLOCK, H * Dh)

    starts = jnp.arange(nb) * Q_BLOCK
    out = lax.map(block, (_to_blocks(q, nb), _to_blocks(F, nb), starts))
    return jnp.moveaxis(out, 0, 1).reshape(B, S, H * Dh)


def setup_inputs(seed: int = 0) -> dict:
    key = jax.random.key(seed)
    ks = jax.random.split(key, 28)
    f32 = jnp.float32

    def nrm(k, shape, fan_in):
        return jax.random.normal(k, shape, f32) * (fan_in ** -0.5)

    def gain(k, n):
        return 1.0 + 0.01 * jax.random.normal(k, (DEPTH, n), f32)

    x = jax.random.normal(ks[0], (BATCH, SEQ, D_MODEL), f32)
    p = jax.random.normal(ks[1], (DEPTH, BATCH, SEQ, PLE_DIM), f32)
    offsets = jax.random.randint(ks[2], (BATCH, 1), 0, 1024) * CHUNK
    positions = (offsets + jnp.arange(SEQ)[None, :]).astype(jnp.int32)
    return {
        "x": x,
        "p": p,
        "positions": positions,
        "g_attn": gain(ks[3], D_MODEL),
        "w_in": nrm(ks[4], (DEPTH, D_MODEL, IN_WIDTH), D_MODEL),
        "g_cq": gain(ks[5], Q_RANK),
        "w_uq": nrm(ks[6], (DEPTH, Q_RANK, W_A), Q_RANK),
        "w_uq_idx": nrm(ks[7], (DEPTH, Q_RANK, N_IDX_HEADS * IDX_DIM), Q_RANK),
        "g_kidx": gain(ks[8], IDX_DIM),
        "b_kidx": 0.01 * jax.random.normal(ks[9], (DEPTH, IDX_DIM), f32),
        "g_q_a": gain(ks[10], HEAD_DIM),
        "g_k_a": gain(ks[11], HEAD_DIM),
        "b_forget": jax.random.uniform(ks[12], (DEPTH, N_HEADS_B), f32, 1.0, 4.0),
        "g_q_b": gain(ks[13], HEAD_DIM),
        "g_k_b": gain(ks[14], HEAD_DIM),
        "w_up_a": nrm(ks[15], (DEPTH, W_A, D_MODEL), W_A),
        "w_up_b": nrm(ks[16], (DEPTH, W_B, D_MODEL), W_B),
        "w_o": nrm(ks[17], (DEPTH, D_MODEL, D_MODEL), D_MODEL),
        "g_ffn": gain(ks[18], D_MODEL),
        "w_ffn_gate": nrm(ks[19], (DEPTH, D_MODEL, D_FF), D_MODEL),
        "w_ffn_up": nrm(ks[20], (DEPTH, D_MODEL, D_FF), D_MODEL),
        "w_ffn_down": nrm(ks[21], (DEPTH, D_FF, D_MODEL), D_FF),
        "g_ple": gain(ks[22], D_MODEL),
        "w_ple": nrm(ks[23], (DEPTH, PLE_DIM, D_MODEL), PLE_DIM),
        "w_ple_gate": nrm(ks[24], (DEPTH, D_MODEL, D_MODEL), D_MODEL),
    }


def reference(x, p, positions, g_attn, w_in, g_cq, w_uq, w_uq_idx, g_kidx, b_kidx,
              g_q_a, g_k_a, b_forget, g_q_b, g_k_b, w_up_a, w_up_b, w_o,
              g_ffn, w_ffn_gate, w_ffn_up, w_ffn_down, g_ple, w_ple, w_ple_gate):
    B, S, _ = x.shape
    top_k = min(INDEX_TOPK, S // 4)
    offs = _split_offsets()
    idx_w_scale = (N_IDX_HEADS ** -0.5) * (IDX_DIM ** -0.5)
    for i in range(DEPTH):
        h = rms_norm(x, g_attn[i])
        proj = h @ w_in[i]
        (c_q, k_a, v_a, k_idx, w_idx, q_b, k_b, v_b, f_b, gate_a, gate_b) = jnp.split(proj, offs, axis=-1)

        c_q = rms_norm(c_q, g_cq[i])
        q_a = rms_norm((c_q @ w_uq[i]).reshape(B, S, N_HEADS_A, HEAD_DIM), g_q_a[i])
        q_a = rope(q_a, positions, HEAD_DIM)
        k_a = rope(rms_norm(k_a.reshape(B, S, N_KV_A, HEAD_DIM), g_k_a[i]), positions, HEAD_DIM)
        v_a = v_a.reshape(B, S, N_KV_A, HEAD_DIM)
        q_idx = rope((c_q @ w_uq_idx[i]).reshape(B, S, N_IDX_HEADS, IDX_DIM), positions, IDX_ROPE_DIM)
        k_idx = rope(layer_norm(k_idx, g_kidx[i], b_kidx[i])[:, :, None, :], positions, IDX_ROPE_DIM)[:, :, 0, :]
        o_a = dsa_sparse_attention(q_a, k_a, v_a, q_idx, k_idx, w_idx * idx_w_scale, top_k)

        q_b = rms_norm(q_b.reshape(B, S, N_HEADS_B, HEAD_DIM), g_q_b[i])
        k_b = rms_norm(k_b.reshape(B, S, N_HEADS_B, HEAD_DIM), g_k_b[i])
        v_b = v_b.reshape(B, S, N_HEADS_B, HEAD_DIM)
        log_f = jax.nn.log_sigmoid((f_b + b_forget[i]).astype(jnp.float32))
        o_b = forgetting_attention(q_b, k_b, v_b, log_f)

        merged = jax.nn.sigmoid(gate_a) * (o_a @ w_up_a[i]) + jax.nn.sigmoid(gate_b) * (o_b @ w_up_b[i])
        x = x + merged @ w_o[i]

        h = rms_norm(x, g_ffn[i])
        x = x + (jax.nn.silu(h @ w_ffn_gate[i]) * (h @ w_ffn_up[i])) @ w_ffn_down[i]

        h = rms_norm(x, g_ple[i])
        x = x + jax.nn.sigmoid(h @ w_ple_gate[i]) * (p[i] @ w_ple[i])
    return x
```

```cpp
#include <hip/hip_runtime.h>
#include <cstdio>
#include <cstdint>

#ifndef MK_N_LAUNCHES
#define MK_N_LAUNCHES 1
#endif
#ifndef MK_PHASE_MASK
#define MK_PHASE_MASK 0x1fff
#endif

#ifndef MK_P2MASK
#define MK_P2MASK 31
#endif
#ifndef MK_CHECK
#define MK_CHECK 0
#endif
#ifndef MK_NAIVE
#define MK_NAIVE 0
#endif
#ifndef MK_SIMPLE
#define MK_SIMPLE 0
#endif
#ifndef MK_DBG
#define MK_DBG 0
#endif
#ifndef MK_ATTN
#define MK_ATTN 3
#endif

#define LAS __attribute__((address_space(3)))
typedef unsigned short bf16_t;
typedef short bf16x8 __attribute__((ext_vector_type(8)));
typedef short s16x4 __attribute__((ext_vector_type(4)));
typedef float f32x2 __attribute__((ext_vector_type(2)));
typedef float f32x4 __attribute__((ext_vector_type(4)));
typedef float f32x16 __attribute__((ext_vector_type(16)));
typedef unsigned u32x2 __attribute__((ext_vector_type(2)));
typedef unsigned u32x4 __attribute__((ext_vector_type(4)));

constexpr int BATCH = 4, SEQ = 4096, DM = 4096, M = BATCH * SEQ;
constexpr int NH = 16, HD = 128, QRANK = 1024, NIH = 32, IDIM = 64, DFF = 11008, PLE = 256, TOPK = 256;
constexpr int INW = 15984;
constexpr int N1 = 16128;
constexpr float EPS = 1e-6f;
constexpr float SM_SCALE = 0.08838834764831845f;
constexpr float INV_SM_SCALE = 11.313708498984761f;

constexpr size_t MiB = 1u << 20;
constexpr size_t WS_CTL = 0, CTL_ZERO_BYTES = 1 * MiB;
constexpr size_t WS_W3T = 1 * MiB;
constexpr size_t WS_WPLET = WS_W3T + 8 * MiB;
constexpr size_t WS_WUPA = WS_WPLET + 2 * MiB;
constexpr size_t WS_WUPB = WS_WUPA + 16 * MiB;
constexpr size_t WS_WO = WS_WUPB + 16 * MiB;
constexpr size_t WS_ROPEA = WS_WO + 32 * MiB;
constexpr size_t WS_ROPEI = WS_ROPEA + 8 * MiB;
constexpr size_t WS_KIDX = WS_ROPEI + 2 * MiB;
constexpr size_t WS_WIDX = WS_KIDX + 2 * MiB;
constexpr size_t WS_BIASK = WS_WIDX + 2 * MiB;
constexpr size_t WS_SELM = WS_BIASK + 1 * MiB;
constexpr size_t WS_PBF = WS_SELM + 8 * MiB;
constexpr size_t WS_KVA = WS_PBF + 8 * MiB;
constexpr size_t WS_MISC = WS_KVA + 16 * MiB;
constexpr size_t WS_RA = WS_MISC + 16 * MiB;
constexpr size_t WS_RB = WS_RA + 128 * MiB;
constexpr size_t WS_RC = WS_RB + 126 * MiB;
constexpr size_t WS_RD = WS_RC + 32 * MiB;
constexpr size_t WS_RG = WS_RD + 192 * MiB;
constexpr size_t WS_WPG = WS_RG + 256 * MiB;
constexpr size_t WS_END = WS_WPG + 32 * MiB;
constexpr size_t WS_ACT = WS_RA;
constexpr size_t WS_WGU = WS_ACT + 344 * MiB;
constexpr size_t WS_WD = WS_WGU + 172 * MiB;
constexpr size_t WS_H2 = WS_RG + 128 * MiB;
constexpr size_t WS_E = WS_WGU;
constexpr size_t WS_SS = WS_CTL + 512 * 1024;
static_assert(WS_RB - WS_RA == (size_t)M * DM * 2 && WS_RC - WS_RB >= (size_t)N1 * DM * 2 && WS_RD - WS_RC == (size_t)M * QRANK * 2, "ws map");
static_assert(WS_RG - WS_RD == (size_t)3 * M * 2048 * 2 && WS_WGU >= WS_RD + (size_t)M * 2048 * 2 * 0 && WS_WD + 86 * MiB <= WS_H2 && WS_END <= 1024 * MiB, "ws map 2");
static_assert(WS_ACT + (size_t)M * DFF * 2 <= WS_WGU, "act vs WGU");
constexpr int CW_BAR = 4096;
constexpr int CW_QFOX = 8192, CW_QIDX = 8193;

constexpr int RING_BYTES = 131072;
constexpr int LDS_BYTES = 147456;
constexpr int LDSCTL_OFF = LDS_BYTES - 1024, MISC_OFF = LDSCTL_OFF + 320;

#define LDS_WAIT() asm volatile("s_waitcnt lgkmcnt(0)" ::: "memory")
#define VM_WAIT() asm volatile("s_waitcnt vmcnt(0)" ::: "memory")
__device__ __forceinline__ unsigned f2bf(float f) { unsigned u = __builtin_bit_cast(unsigned, f); return (u + 0x7fffu + ((u >> 16) & 1u)) >> 16; }
__device__ __forceinline__ unsigned pk2(float lo, float hi) { return f2bf(lo) | (f2bf(hi) << 16); }
__device__ __forceinline__ float bf2f(unsigned short b) { return __builtin_bit_cast(float, (unsigned)b << 16); }
__device__ __forceinline__ float bflo(unsigned w) { return __builtin_bit_cast(float, w << 16); }
__device__ __forceinline__ float bfhi(unsigned w) { return __builtin_bit_cast(float, w & 0xffff0000u); }
__device__ __forceinline__ unsigned cvtpk(float lo, float hi) { unsigned r; asm volatile("v_cvt_pk_bf16_f32 %0, %1, %2" : "=v"(r) : "v"(lo), "v"(hi)); return r; }
__device__ __forceinline__ float sigmoidf_(float x) { return __builtin_amdgcn_rcpf(1.0f + __builtin_amdgcn_exp2f(-1.4426950408889634f * x)); }
__device__ __forceinline__ float wave_sum(float v) {
#pragma unroll
    for (int o = 1; o < 64; o <<= 1) v += __shfl_xor(v, o);
    return v;
}

#define XB_TMO      128
#define XB_XCNT(j)  (256  + 64 * (j))
#define XB_XSUB(j)  (1280 + 64 * (j))
#define XB_XGEN(j)  (2304 + 64 * (j))
#define XB_TOP      3328
#define XB_TOPGEN   3392
#define XCD_BAR_WORDS 3456
#define XB_SPIN_CAP (1u << 18)
__device__ __forceinline__ unsigned xb_ld(unsigned* p)              { return __hip_atomic_load(p, __ATOMIC_RELAXED, __HIP_MEMORY_SCOPE_AGENT); }
__device__ __forceinline__ unsigned xb_add(unsigned* p, unsigned v) { return __hip_atomic_fetch_add(p, v, __ATOMIC_RELAXED, __HIP_MEMORY_SCOPE_AGENT); }
__device__ __forceinline__ unsigned xb_xcc_id() { return (unsigned)__builtin_amdgcn_s_getreg((3 << 11) | 20) & 0xFu; }
#define XB_SPIN(cond, bar) do { unsigned _sp = 0; while (cond) { __builtin_amdgcn_s_sleep(1); \
    if ((++_sp & 255u) == 0u) { if (xb_ld(&(bar)[XB_TMO])) break; if (_sp > XB_SPIN_CAP) { atomicAdd(&(bar)[XB_TMO], 1u); break; } } } } while (0)
struct XcdBarrier { unsigned* bar; unsigned x; volatile LAS unsigned* st; };
__device__ __forceinline__ XcdBarrier xcd_barrier_post(unsigned* bar, volatile LAS unsigned* st) {
    XcdBarrier b; b.bar = bar; b.x = xb_xcc_id(); b.st = st;
    if (threadIdx.x == 0) (void)xb_add(&bar[XB_XCNT(b.x)], 1u);
    return b;
}
__device__ __forceinline__ void xcd_barrier_complete(unsigned* bar, unsigned x, unsigned& nloc, unsigned& nx) {
    const unsigned G = gridDim.x * gridDim.y * gridDim.z;
    unsigned sum, cnt, mine, sp = 0u;
    for (;;) {
        sum = 0u; cnt = 0u; mine = 0u;
#pragma unroll
        for (unsigned j = 0; j < 16; ++j) { const unsigned c = xb_ld(&bar[XB_XCNT(j)]); sum += c; cnt += (c > 0u) ? 1u : 0u; mine = (j == x) ? c : mine; }
        if (sum == G) break;
        __builtin_amdgcn_s_sleep(1);
        if ((++sp & 255u) == 0u) { if (xb_ld(&bar[XB_TMO])) break; if (sp > XB_SPIN_CAP) { atomicAdd(&bar[XB_TMO], 1u); break; } }
    }
    nloc = mine > 0u ? mine : 1u; nx = cnt > 0u ? cnt : 1u;
}
__device__ __forceinline__ void xcd_barrier(const XcdBarrier& b) {
    asm volatile("s_waitcnt vmcnt(0)" ::: "memory");
    __syncthreads();
    if (threadIdx.x == 0) {
        unsigned* bar = b.bar;
        __builtin_amdgcn_s_waitcnt(0);
        unsigned nloc = b.st[0], nx = b.st[1];
        if (nloc == 0u) { xcd_barrier_complete(bar, b.x, nloc, nx); b.st[0] = nloc; b.st[1] = nx; }
        const unsigned old = xb_add(&bar[XB_XSUB(b.x)], 1u);
        const unsigned gen = old / nloc;
        if (old + 1u == (gen + 1u) * nloc) {
            __builtin_amdgcn_fence(__ATOMIC_RELEASE, "agent");
            asm volatile("s_waitcnt vmcnt(0)" ::: "memory");
            const unsigned og = xb_add(&bar[XB_TOP], 1u);
            const unsigned tg = og / nx;
            if (og + 1u == (tg + 1u) * nx) xb_add(&bar[XB_TOPGEN], 1u);
            else XB_SPIN(xb_ld(&bar[XB_TOPGEN]) == tg, bar);
            __builtin_amdgcn_fence(__ATOMIC_ACQUIRE, "agent");
            xb_add(&bar[XB_XGEN(b.x)], 1u);
            asm volatile("s_waitcnt vmcnt(0)" ::: "memory");
        } else {
            XB_SPIN(xb_ld(&bar[XB_XGEN(b.x)]) == gen, bar);
            __builtin_amdgcn_fence(__ATOMIC_ACQUIRE, "agent");
            asm volatile("s_waitcnt vmcnt(0)" ::: "memory");
        }
    }
    __syncthreads();
}

namespace pg8 {
constexpr int BM = 256, BK = 64, HALF = 128, HTB = HALF * BK * 2, STAGE_BYTES = 8 * HTB, NXCD = 8, WGM = 8;
__host__ __device__ __forceinline__ int lds_byte(int r, int c) { const int st = (r >> 4) * 2 + (c >> 5), rr = r & 15, cc = c & 31, ob = rr * 64 + cc * 2; return st * 1024 + (ob ^ (((ob >> 9) & 1) << 5)); }
__host__ __device__ __forceinline__ void stage_rc(int b, int& R, int& C) { const int st = b / 1024, sb = b % 1024, swz = sb ^ (((sb >> 9) & 1) << 5); R = (st >> 1) * 16 + swz / 64; C = (st & 1) * 32 + (swz % 64) / 2; }
__host__ __device__ __forceinline__ int perm32(int rho) { const int n = rho >> 4, i = rho & 15; return 8 * (i >> 2) + 4 * n + (i & 3); }

struct Unit { int pm, pn, z; };
struct Gemm { const bf16_t* A; const bf16_t* Bt; const bf16_t* A2; const bf16_t* Bt2; int M, N, K; };

struct StaticOrder {
    int nM, nN, nwg, G, c;
    __host__ __device__ void init(int M_, int N_, int G_, int c_) { nM = M_ / BM; nN = N_ / BM; nwg = nM * nN; G = G_; c = c_; }
    __host__ __device__ bool next(int i, Unit& u) const {
        const long L = (long)i * G + c; if (L >= nwg) return false;
        int wgid = (int)L; { const int q = nwg / NXCD, r = nwg % NXCD, xcd = wgid % NXCD, off = wgid / NXCD; wgid = (xcd < r ? xcd * (q + 1) : r * (q + 1) + (xcd - r) * q) + off; }
        const int nig = WGM * nN, gid = wgid / nig, fm = gid * WGM, gsz = (nM - fm) < WGM ? (nM - fm) : WGM;
        u.pm = fm + ((wgid % nig) % gsz); u.pn = (wgid % nig) / gsz; u.z = 0; return true;
    }
    __device__ __forceinline__ void a_ready(const Unit&) const {}
    __device__ __forceinline__ void done(const Unit&) const {}
};
struct DualOrder : StaticOrder {
    __host__ __device__ bool next(int i, Unit& u) const { const bool ok = StaticOrder::next(i >> 1, u); u.z = i & 1; return ok; }
};

template <class Epi, class Sched, bool ALIGN_EPI = true, bool SP2 = true>
__device__ __forceinline__ void gemm_phase(LAS unsigned char* lds, const Gemm g, const Sched& S, const Epi& E) {
    const int tid = threadIdx.x, wid = __builtin_amdgcn_readfirstlane(tid >> 6), lane = tid & 63, wr = wid >> 2, wc = wid & 3, fr = lane & 15, fq = lane >> 4;
    const int K = g.K, nt = K / BK;
    unsigned voffA[2], voffB[2];
#pragma unroll
    for (int i = 0; i < 2; ++i) { int R, C; stage_rc(tid * 16 + i * 8192, R, C); const int Rb = Epi::PERM ? ((R & ~31) + perm32(R & 31)) : R;
        voffA[i] = (unsigned)(R * K + C) * 2u; voffB[i] = (unsigned)(Rb * K + C) * 2u; }
    const size_t kstep = (size_t)(BK * 2);
    const size_t hstep = (size_t)HALF * K * 2;
    const size_t tstep = 2 * hstep;
    const unsigned ldsw = (unsigned)wid * 1024u;
    const int aoff = lds_byte(wr * 64 + fr, fq * 8), boff = lds_byte(wc * 32 + fr, fq * 8);
#define PG8_SA(b, h) (((b) * 2 + (h)) * HTB)
#define PG8_SB(b, h) ((4 + (b) * 2 + (h)) * HTB)
#define PG8_STAGE(bufoff, gbase, voff) do { _Pragma("unroll") for (int _i = 0; _i < 2; ++_i) \
        __builtin_amdgcn_global_load_lds((const unsigned*)((const char*)(gbase) + (voff)[_i]), (LAS unsigned*)(lds + (bufoff) + ldsw + _i * 8192), 16, 0, 0); } while (0)
#define PG8_LDA(dst, b, h) do { _Pragma("unroll") for (int m = 0; m < 4; ++m) _Pragma("unroll") for (int k = 0; k < 2; ++k) dst[m][k] = *(const LAS bf16x8*)(lds + PG8_SA(b, h) + aoff + m * 2048 + k * 1024); } while (0)
#define PG8_LDB(dst, b, h) do { _Pragma("unroll") for (int n = 0; n < 2; ++n) _Pragma("unroll") for (int k = 0; k < 2; ++k) dst[n][k] = *(const LAS bf16x8*)(lds + PG8_SB(b, h) + boff + n * 2048 + k * 1024); } while (0)
#define PG8_MMA(ai, bj, At, Bt) do { __builtin_amdgcn_s_setprio(1); _Pragma("unroll") for (int m = 0; m < 4; ++m) _Pragma("unroll") for (int n = 0; n < 2; ++n) _Pragma("unroll") for (int k = 0; k < 2; ++k) \
        acc[ai][bj][m][n] = __builtin_amdgcn_mfma_f32_16x16x32_bf16(Bt[n][k], At[m][k], acc[ai][bj][m][n], 0, 0, 0); __builtin_amdgcn_s_setprio(0); } while (0)
#define PG8_WAIT_V(n) asm volatile("s_waitcnt vmcnt(" #n ")" ::: "memory")
#define PG8_WAIT_L(n) asm volatile("s_waitcnt lgkmcnt(" #n ")" ::: "memory")
#define PG8_BAR __builtin_amdgcn_s_barrier()
#define PG8_SCHED __builtin_amdgcn_sched_barrier(0)
#define PG8_ABASE(u) ((const char*)((u).z ? g.A2 : g.A) + (size_t)(u).pm * tstep)
#define PG8_BBASE(u) ((const char*)((u).z ? g.Bt2 : g.Bt) + (size_t)(u).pn * tstep)
    Unit cur, nxt; int ui = 0;
    if (!S.next(0, cur)) return;
    f32x4 acc[2][2][4][2];
#pragma unroll
    for (int a = 0; a < 2; ++a)
#pragma unroll
        for (int b = 0; b < 2; ++b)
#pragma unroll
            for (int m = 0; m < 4; ++m)
#pragma unroll
                for (int n = 0; n < 2; ++n) acc[a][b][m][n] = (f32x4){0.f, 0.f, 0.f, 0.f};
    bf16x8 At[4][2], B0[2][2], B1[2][2];
    const char* cA = PG8_ABASE(cur); const char* cB = PG8_BBASE(cur);
    S.a_ready(cur);
    if constexpr (SP2) {
        PG8_STAGE(PG8_SB(0, 0), cB, voffB); PG8_STAGE(PG8_SB(0, 1), cB + hstep, voffB); PG8_STAGE(PG8_SA(0, 0), cA, voffA); PG8_STAGE(PG8_SA(0, 1), cA + hstep, voffA);
        if (wr == 1) PG8_BAR;
        PG8_WAIT_V(2); PG8_BAR;
        PG8_STAGE(PG8_SB(1, 0), cB + kstep, voffB); PG8_STAGE(PG8_SA(1, 0), cA + kstep, voffA); PG8_STAGE(PG8_SB(1, 1), cB + hstep + kstep, voffB);
        PG8_WAIT_V(6); PG8_BAR;
    } else {
        PG8_STAGE(PG8_SB(0, 0), cB, voffB); PG8_STAGE(PG8_SA(0, 0), cA, voffA); PG8_STAGE(PG8_SB(0, 1), cB + hstep, voffB); PG8_STAGE(PG8_SA(0, 1), cA + hstep, voffA);
        if (wr == 1) PG8_BAR;
        PG8_WAIT_V(4); PG8_BAR;
        PG8_STAGE(PG8_SB(1, 0), cB + kstep, voffB); PG8_STAGE(PG8_SA(1, 0), cA + kstep, voffA); PG8_STAGE(PG8_SB(1, 1), cB + hstep + kstep, voffB);
        PG8_WAIT_V(6); PG8_BAR;
    }
    for (;;) {
        const bool has_next = S.next(ui + 1, nxt);
        const char* nA = has_next ? PG8_ABASE(nxt) : cA; const char* nB = has_next ? PG8_BBASE(nxt) : cB;
        for (int t = 0; t < nt; t += 2) {
            const bool last = (t == nt - 2);
            const char* a1 = cA + (size_t)(t + 1) * kstep;
            const char* a2 = last ? nA : cA + (size_t)(t + 2) * kstep; const char* b2 = last ? nB : cB + (size_t)(t + 2) * kstep;
            const char* a3 = a2 + kstep; const char* b3 = b2 + kstep;
            if (last && has_next) S.a_ready(nxt);
            if constexpr (SP2) {
            PG8_LDB(B0, 0, 0); PG8_LDB(B1, 0, 1); PG8_SCHED; PG8_LDA(At, 0, 0); PG8_STAGE(PG8_SA(1, 1), a1 + hstep, voffA);
            PG8_WAIT_V(8); PG8_WAIT_L(0); PG8_BAR; PG8_MMA(0, 0, At, B0); PG8_MMA(0, 1, At, B1); PG8_BAR; PG8_SCHED;
            PG8_LDA(At, 0, 1); PG8_STAGE(PG8_SB(0, 0), b2, voffB); PG8_STAGE(PG8_SB(0, 1), b2 + hstep, voffB); PG8_STAGE(PG8_SA(0, 0), a2, voffA);
            PG8_WAIT_V(8); PG8_WAIT_L(0); PG8_BAR; PG8_MMA(1, 0, At, B0); PG8_MMA(1, 1, At, B1); PG8_BAR; PG8_SCHED;
            PG8_LDB(B0, 1, 0); PG8_LDB(B1, 1, 1); PG8_SCHED; PG8_LDA(At, 1, 0); PG8_STAGE(PG8_SA(0, 1), a2 + hstep, voffA);
            PG8_WAIT_V(8); PG8_WAIT_L(0); PG8_BAR; PG8_MMA(0, 0, At, B0); PG8_MMA(0, 1, At, B1); PG8_BAR; PG8_SCHED;
            PG8_LDA(At, 1, 1); PG8_STAGE(PG8_SB(1, 0), b3, voffB); PG8_STAGE(PG8_SB(1, 1), b3 + hstep, voffB); PG8_STAGE(PG8_SA(1, 0), a3, voffA);
            PG8_WAIT_V(8); PG8_WAIT_L(0); PG8_BAR; PG8_MMA(1, 0, At, B0); PG8_MMA(1, 1, At, B1); PG8_BAR; PG8_SCHED;
            } else {
            PG8_LDB(B0, 0, 0); PG8_SCHED; PG8_LDA(At, 0, 0); PG8_STAGE(PG8_SA(1, 1), a1 + hstep, voffA);
            PG8_WAIT_L(8); PG8_BAR; PG8_WAIT_L(0); PG8_MMA(0, 0, At, B0); PG8_BAR; PG8_SCHED;
            PG8_LDB(B1, 0, 1); PG8_STAGE(PG8_SB(0, 0), b2, voffB);
            PG8_BAR; PG8_WAIT_L(0); PG8_MMA(0, 1, At, B1); PG8_BAR;
            PG8_LDA(At, 0, 1); PG8_STAGE(PG8_SA(0, 0), a2, voffA);
            PG8_BAR; PG8_WAIT_L(0); PG8_MMA(1, 0, At, B0); PG8_BAR; PG8_SCHED;
            PG8_STAGE(PG8_SB(0, 1), b2 + hstep, voffB);
            PG8_WAIT_V(6); PG8_BAR; PG8_MMA(1, 1, At, B1); PG8_BAR;
            PG8_LDB(B0, 1, 0); PG8_SCHED; PG8_LDA(At, 1, 0); PG8_STAGE(PG8_SA(0, 1), a2 + hstep, voffA);
            PG8_WAIT_L(8); PG8_BAR; PG8_WAIT_L(0); PG8_MMA(0, 0, At, B0); PG8_BAR; PG8_SCHED;
            PG8_LDB(B1, 1, 1); PG8_STAGE(PG8_SB(1, 0), b3, voffB);
            PG8_BAR; PG8_WAIT_L(0); PG8_MMA(0, 1, At, B1); PG8_BAR;
            PG8_LDA(At, 1, 1); PG8_STAGE(PG8_SA(1, 0), a3, voffA);
            PG8_BAR; PG8_WAIT_L(0); PG8_MMA(1, 0, At, B0); PG8_BAR; PG8_SCHED;
            PG8_STAGE(PG8_SB(1, 1), b3 + hstep, voffB);
            PG8_WAIT_V(6); PG8_BAR; PG8_MMA(1, 1, At, B1); PG8_BAR;
            }
        }
        if constexpr (ALIGN_EPI) { if (wr == 0) PG8_BAR; }
        E(acc, cur, wr, wc, fr, fq);
        if (!has_next) break;
        if (!(Epi::KEEP_Z0 && cur.z == 0))
#pragma unroll
        for (int a = 0; a < 2; ++a)
#pragma unroll
            for (int b = 0; b < 2; ++b)
#pragma unroll
                for (int m = 0; m < 4; ++m)
#pragma unroll
                    for (int n = 0; n < 2; ++n) acc[a][b][m][n] = (f32x4){0.f, 0.f, 0.f, 0.f};
        cur = nxt; cA = nA; cB = nB; ++ui;
        if constexpr (ALIGN_EPI) { if (wr == 1) PG8_BAR; }
    }
    PG8_WAIT_V(0);
    if constexpr (!ALIGN_EPI) { if (wr == 0) PG8_BAR; }
    PG8_BAR;
#undef PG8_SA
#undef PG8_SB
#undef PG8_STAGE
#undef PG8_LDA
#undef PG8_LDB
#undef PG8_MMA
#undef PG8_WAIT_V
#undef PG8_WAIT_L
#undef PG8_BAR
#undef PG8_SCHED
#undef PG8_ABASE
#undef PG8_BBASE
}

#define EPI_ROWS_BEGIN _Pragma("unroll") for (int ai = 0; ai < 2; ++ai) _Pragma("unroll") for (int m = 0; m < 4; ++m) { const size_t row = (size_t)(u.pm * BM + ai * HALF + wr * 64 + m * 16 + fr);
#define EPI_ROWS_END }
__device__ __forceinline__ u32x4 pack8f(f32x4 a, f32x4 b) { u32x4 w; w.x = cvtpk(a[0], a[1]); w.y = cvtpk(a[2], a[3]); w.z = cvtpk(b[0], b[1]); w.w = cvtpk(b[2], b[3]); return w; }
__device__ __forceinline__ void unpack8f(u32x4 w, f32x4& a, f32x4& b) { a = (f32x4){bflo(w.x), bfhi(w.x), bflo(w.y), bfhi(w.y)}; b = (f32x4){bflo(w.z), bfhi(w.z), bflo(w.w), bfhi(w.w)}; }
__device__ __forceinline__ f32x4 sig4(f32x4 v) { return (f32x4){sigmoidf_(v[0]), sigmoidf_(v[1]), sigmoidf_(v[2]), sigmoidf_(v[3])}; }

struct EpiP1 {
    static constexpr bool PERM = true, KEEP_Z0 = false;
    bf16_t *cq, *kva, *qkvb, *gates; float* misc; const float* gqb; const float* gkb; LAS float* xch;
    __device__ __forceinline__ void operator()(const f32x4 (&acc)[2][2][4][2], const Unit& u, int wr, int wc, int fr, int fq) const {
        const int pn = u.pn, cl = wc * 32 + 8 * fq;
        if (pn >= 7 && pn < 23) {
            const int t = (pn - 7) >> 3;
            const float* gp = (t ? gkb : gqb) + cl;
            const f32x4 g0 = *(const f32x4*)gp, g1 = *(const f32x4*)(gp + 4);
#pragma unroll
            for (int ai = 0; ai < 2; ++ai)
#pragma unroll
                for (int m = 0; m < 4; ++m)
#pragma unroll
                    for (int bj = 0; bj < 2; ++bj) { const f32x4 a0 = acc[ai][bj][m][0], a1 = acc[ai][bj][m][1];
                        float v = (a0[0] * a0[0] + a0[1] * a0[1]) + (a0[2] * a0[2] + a0[3] * a0[3]) + (a1[0] * a1[0] + a1[1] * a1[1]) + (a1[2] * a1[2] + a1[3] * a1[3]);
                        v += __shfl_xor(v, 16); v += __shfl_xor(v, 32);
                        if (fq == 0) xch[((((wr * 2 + ai) * 4 + m) * 16 + fr) * 2 + bj) * 4 + wc] = v; }
            LDS_WAIT(); __builtin_amdgcn_s_barrier();
            bf16_t* base = qkvb + (size_t)t * ((size_t)M * 2048) + ((pn - 7) & 7) * 256 + cl;
            EPI_ROWS_BEGIN
                bf16_t* rowp = base + row * 2048;
#pragma unroll
                for (int bj = 0; bj < 2; ++bj) { const f32x4 p4 = *(const LAS f32x4*)(xch + ((((wr * 2 + ai) * 4 + m) * 16 + fr) * 2 + bj) * 4);
                    const float rstd = 1.0f / sqrtf(((p4[0] + p4[1]) + (p4[2] + p4[3])) * (1.f / 128.f) + EPS);
                    *(u32x4*)(rowp + bj * HALF) = pack8f(acc[ai][bj][m][0] * rstd * g0, acc[ai][bj][m][1] * rstd * g1); }
            EPI_ROWS_END
            return;
        }
        if (pn == 6) {
            EPI_ROWS_BEGIN
                float* rowp = misc + row * 256 + cl;
#pragma unroll
                for (int bj = 0; bj < 2; ++bj) { *(f32x4*)(rowp + bj * HALF) = acc[ai][bj][m][0]; *(f32x4*)(rowp + bj * HALF + 4) = acc[ai][bj][m][1]; }
            EPI_ROWS_END
            return;
        }
        bf16_t* base; int ldc;
        if (pn >= 31) { base = gates + (pn - 31) * 256; ldc = 8192; }
        else if (pn < 4) { base = cq + pn * 256; ldc = 1024; }
        else if (pn < 6) { base = kva + (pn - 4) * 256; ldc = 512; }
        else { const int t = (pn - 7) >> 3; base = qkvb + (size_t)t * ((size_t)M * 2048) + ((pn - 7) & 7) * 256; ldc = 2048; }
        base += cl;
        EPI_ROWS_BEGIN
            bf16_t* rowp = base + row * ldc;
#pragma unroll
            for (int bj = 0; bj < 2; ++bj) *(u32x4*)(rowp + bj * HALF) = pack8f(acc[ai][bj][m][0], acc[ai][bj][m][1]);
        EPI_ROWS_END
    }
};
struct EpiBf16 {
    static constexpr bool PERM = true, KEEP_Z0 = false;
    bf16_t* O; int ldc; int split_cols; size_t split_stride;
    __device__ __forceinline__ void operator()(const f32x4 (&acc)[2][2][4][2], const Unit& u, int wr, int wc, int fr, int fq) const {
        int colt = u.pn * BM; bf16_t* base = O;
        if (split_cols) { const int t = colt / split_cols; base += (size_t)t * split_stride; colt -= t * split_cols; }
        base += colt + wc * 32 + 8 * fq;
        EPI_ROWS_BEGIN
            bf16_t* rowp = base + row * ldc;
#pragma unroll
            for (int bj = 0; bj < 2; ++bj) *(u32x4*)(rowp + bj * HALF) = pack8f(acc[ai][bj][m][0], acc[ai][bj][m][1]);
        EPI_ROWS_END
    }
};
struct EpiMerge {
    static constexpr bool PERM = true, KEEP_Z0 = true;
    const bf16_t* gates; bf16_t* merged;
    static __device__ __forceinline__ float en(float x) { return __builtin_amdgcn_exp2f(-1.4426950408889634f * x); }
    __device__ __forceinline__ void operator()(f32x4 (&acc)[2][2][4][2], const Unit& u, int wr, int wc, int fr, int fq) const {
        const int col = u.pn * BM + wc * 32 + 8 * fq;
        if (u.z == 0) {
#pragma unroll
            for (int ai = 0; ai < 2; ++ai) {
                const size_t row0 = (size_t)(u.pm * BM + ai * HALF + wr * 64 + fr);
                u32x4 ga[4][2], gb[4][2];
#pragma unroll
                for (int m = 0; m < 4; ++m)
#pragma unroll
                    for (int bj = 0; bj < 2; ++bj) { const bf16_t* p = gates + (row0 + m * 16) * 8192 + col + bj * HALF; ga[m][bj] = *(const u32x4*)p; gb[m][bj] = *(const u32x4*)(p + 4096); }
                asm volatile("" ::: "memory");
#pragma unroll
                for (int m = 0; m < 4; ++m)
#pragma unroll
                    for (int bj = 0; bj < 2; ++bj) { f32x4 a0, a1, b0, b1; unpack8f(ga[m][bj], a0, a1); unpack8f(gb[m][bj], b0, b1);
#pragma unroll
                        for (int j = 0; j < 4; ++j) {
                            acc[ai][bj][m][0][j] *= (1.0f + en(fmaxf(b0[j], -60.f))) * __builtin_amdgcn_rcpf(1.0f + en(a0[j]));
                            acc[ai][bj][m][1][j] *= (1.0f + en(fmaxf(b1[j], -60.f))) * __builtin_amdgcn_rcpf(1.0f + en(a1[j])); } }
                asm volatile("" ::: "memory");
            }
            return;
        }
#pragma unroll
        for (int ai = 0; ai < 2; ++ai) {
            const size_t row0 = (size_t)(u.pm * BM + ai * HALF + wr * 64 + fr);
            u32x4 gb[4][2];
#pragma unroll
            for (int m = 0; m < 4; ++m)
#pragma unroll
                for (int bj = 0; bj < 2; ++bj) gb[m][bj] = *(const u32x4*)(gates + (row0 + m * 16) * 8192 + 4096 + col + bj * HALF);
            asm volatile("" ::: "memory");
#pragma unroll
            for (int m = 0; m < 4; ++m)
#pragma unroll
                for (int bj = 0; bj < 2; ++bj) { f32x4 b0, b1, s0, s1; unpack8f(gb[m][bj], b0, b1);
#pragma unroll
                    for (int j = 0; j < 4; ++j) { s0[j] = __builtin_amdgcn_rcpf(1.0f + en(fmaxf(b0[j], -60.f))); s1[j] = __builtin_amdgcn_rcpf(1.0f + en(fmaxf(b1[j], -60.f))); }
                    *(u32x4*)(merged + (row0 + m * 16) * 4096 + col + bj * HALF) = pack8f(acc[ai][bj][m][0] * s0, acc[ai][bj][m][1] * s1); }
            asm volatile("" ::: "memory");
        }
    }
};
struct EpiResid {
    static constexpr bool PERM = true, KEEP_Z0 = false;
    const float* base; float* out;
    __device__ __forceinline__ void operator()(const f32x4 (&acc)[2][2][4][2], const Unit& u, int wr, int wc, int fr, int fq) const {
        const int col = u.pn * BM + wc * 32 + 8 * fq;
        EPI_ROWS_BEGIN
#pragma unroll
            for (int bj = 0; bj < 2; ++bj) { const size_t o = row * 4096 + col + bj * HALF;
                const f32x4 b0 = *(const f32x4*)(base + o), b1 = *(const f32x4*)(base + o + 4);
                *(f32x4*)(out + o) = b0 + acc[ai][bj][m][0]; *(f32x4*)(out + o + 4) = b1 + acc[ai][bj][m][1]; }
            if (m & 1) asm volatile("" ::: "memory");
        EPI_ROWS_END
    }
};
template <bool BASE_BF16>
struct EpiResidNorm {
    static constexpr bool PERM = true, KEEP_Z0 = false;
    const void* base; bf16_t* xb; float* ss;
    __device__ __forceinline__ void operator()(const f32x4 (&acc)[2][2][4][2], const Unit& u, int wr, int wc, int fr, int fq) const {
        const int col = u.pn * BM + wc * 32 + 8 * fq;
#pragma unroll
        for (int ai = 0; ai < 2; ++ai) {
            const size_t row0 = (size_t)(u.pm * BM + ai * HALF + wr * 64 + fr);
            f32x4 bq[4][2][2];
            if (BASE_BF16) {
                u32x4 raw[4][2];
#pragma unroll
                for (int m = 0; m < 4; ++m)
#pragma unroll
                    for (int bj = 0; bj < 2; ++bj) raw[m][bj] = *(const u32x4*)((const bf16_t*)base + (row0 + m * 16) * 4096 + col + bj * HALF);
                asm volatile("" ::: "memory");
#pragma unroll
                for (int m = 0; m < 4; ++m)
#pragma unroll
                    for (int bj = 0; bj < 2; ++bj) unpack8f(raw[m][bj], bq[m][bj][0], bq[m][bj][1]);
            } else {
#pragma unroll
                for (int m = 0; m < 4; ++m)
#pragma unroll
                    for (int bj = 0; bj < 2; ++bj) { const float* p = (const float*)base + (row0 + m * 16) * 4096 + col + bj * HALF; bq[m][bj][0] = *(const f32x4*)p; bq[m][bj][1] = *(const f32x4*)(p + 4); }
                asm volatile("" ::: "memory");
            }
#pragma unroll
            for (int m = 0; m < 4; ++m) { const size_t row = row0 + m * 16;
                float sq = 0.f;
#pragma unroll
                for (int bj = 0; bj < 2; ++bj) { const size_t o = row * 4096 + col + bj * HALF;
                    const f32x4 v0 = bq[m][bj][0] + acc[ai][bj][m][0], v1 = bq[m][bj][1] + acc[ai][bj][m][1];
                    *(u32x4*)(xb + o) = pack8f(v0, v1);
                    sq += (v0[0] * v0[0] + v0[1] * v0[1]) + (v0[2] * v0[2] + v0[3] * v0[3]) + (v1[0] * v1[0] + v1[1] * v1[1]) + (v1[2] * v1[2] + v1[3] * v1[3]); }
                sq += __shfl_xor(sq, 16); sq += __shfl_xor(sq, 32);
                if (fq == 0) atomicAdd(ss + row, sq); }
            asm volatile("" ::: "memory");
        }
    }
};
struct EpiSwiGLU {
    static constexpr bool PERM = true, KEEP_Z0 = false;
    bf16_t* act; const float* ss;
    __device__ __forceinline__ void operator()(const f32x4 (&acc)[2][2][4][2], const Unit& u, int wr, int wc, int fr, int fq) const {
        bf16_t* base = act + u.pn * HALF + wc * 32 + 8 * fq;
        float sq[2][4];
#pragma unroll
        for (int ai = 0; ai < 2; ++ai)
#pragma unroll
            for (int m = 0; m < 4; ++m) sq[ai][m] = ss[u.pm * BM + ai * HALF + wr * 64 + m * 16 + fr];
        asm volatile("" ::: "memory");
        EPI_ROWS_BEGIN
            const float r = 1.0f / sqrtf(sq[ai][m] * (1.f / 4096.f) + EPS);
            const f32x4 g0 = acc[ai][0][m][0] * r, g1 = acc[ai][0][m][1] * r;
            *(u32x4*)(base + row * DFF) = pack8f(g0 * sig4(g0) * (acc[ai][1][m][0] * r), g1 * sig4(g1) * (acc[ai][1][m][1] * r));
        EPI_ROWS_END
    }
};
struct EpiPle {
    static constexpr bool PERM = true, KEEP_Z0 = false;
    const bf16_t* E; const bf16_t* x2; float* out; const float* ss;
    __device__ __forceinline__ void operator()(const f32x4 (&acc)[2][2][4][2], const Unit& u, int wr, int wc, int fr, int fq) const {
        const int col = u.pn * BM + wc * 32 + 8 * fq;
#pragma unroll
        for (int ai = 0; ai < 2; ++ai) {
            const size_t row0 = (size_t)(u.pm * BM + ai * HALF + wr * 64 + fr);
            u32x4 eq[4][2], xq[4][2]; float sq[4];
#pragma unroll
            for (int m = 0; m < 4; ++m) { sq[m] = ss[row0 + m * 16];
#pragma unroll
                for (int bj = 0; bj < 2; ++bj) { const size_t o = (row0 + m * 16) * 4096 + col + bj * HALF;
                    eq[m][bj] = *(const u32x4*)(E + o); xq[m][bj] = *(const u32x4*)(x2 + o); } }
            asm volatile("" ::: "memory");
#pragma unroll
            for (int m = 0; m < 4; ++m) {
                const float r = 1.0f / sqrtf(sq[m] * (1.f / 4096.f) + EPS);
#pragma unroll
                for (int bj = 0; bj < 2; ++bj) { const size_t o = (row0 + m * 16) * 4096 + col + bj * HALF;
                    f32x4 e0, e1, b0, b1; unpack8f(eq[m][bj], e0, e1); unpack8f(xq[m][bj], b0, b1);
                    *(f32x4*)(out + o) = b0 + sig4(acc[ai][bj][m][0] * r) * e0; *(f32x4*)(out + o + 4) = b1 + sig4(acc[ai][bj][m][1] * r) * e1; } }
            asm volatile("" ::: "memory");
        }
    }
};
#undef EPI_ROWS_BEGIN
#undef EPI_ROWS_END
}

namespace fa {
constexpr int NW = 8, QBLK = 32, KVBLK = 64, QB = NW * QBLK, D = 128;
constexpr int SHM_V = KVBLK * D * 2, SHM_K = KVBLK * D * 2;
constexpr int LDS_USE = 2 * SHM_V + 2 * SHM_K + NW * 64 * 4;
constexpr float THR = 8.f;
#define KSWZ(row, colB) ((row) * 256 + ((colB) ^ (((row) & 7) << 4)))
#ifdef FA_HEAVY
#define SBAR() do { asm volatile("s_waitcnt vmcnt(0) lgkmcnt(0)" ::: "memory"); __syncthreads(); } while (0)
#else
#define SBAR() __builtin_amdgcn_sched_barrier(0)
#endif
__device__ __forceinline__ int v_st(int k, int c) { const int kk = (k & ~0xC) | ((k & 4) << 1) | ((k & 8) >> 1); return ((kk >> 3) * 4 + (c >> 5)) * 512 + ((kk & 7) * 32 + (c & 31)) * 2; }
__device__ __forceinline__ int v_rd_base(int lane) { return ((lane & 3) << 3) | (((lane >> 2) & 3) << 6) | (((lane >> 4) & 1) << 5) | (((lane >> 5) & 1) << 8); }
constexpr int v_rd_off(int d0, int ks, int half) { return d0 * 512 + ks * 4096 + half * 2048; }
__device__ __forceinline__ int crow(int r, int hi) { return (r & 3) + 8 * (r >> 2) + 4 * hi; }

__device__ __forceinline__ void mask_causal(f32x16& p0, f32x16& p1, int dq) {
    const float NEG = -__builtin_inff();
#pragma unroll
    for (int r = 0; r < 16; ++r) {
        const int c = (r & 3) + 8 * (r >> 2);
        if (dq - c < 0) p0[r] = NEG;
        if (dq - c - 32 < 0) p1[r] = NEG;
    }
}
__device__ __forceinline__ void mask_bits(f32x16& p0, f32x16& p1, unsigned long long mk, int hi) {
    const float NEG = -__builtin_inff();
    const unsigned lo = (unsigned)mk >> (4 * hi), hh = (unsigned)(mk >> 32) >> (4 * hi);
#pragma unroll
    for (int r = 0; r < 16; ++r) {
        const int c = (r & 3) + 8 * (r >> 2);
        if (!(lo & (1u << c))) p0[r] = NEG;
        if (!(hh & (1u << c))) p1[r] = NEG;
    }
}
__device__ __forceinline__ void partialSM(f32x16& p0, f32x16& p1, float& m_reg, float& mn, float& alpha) {
    float pmax = p0[0];
#pragma unroll
    for (int r = 1; r < 16; ++r) pmax = fmaxf(pmax, p0[r]);
#pragma unroll
    for (int r = 0; r < 16; ++r) pmax = fmaxf(pmax, p1[r]);
    { auto rr = __builtin_amdgcn_permlane32_swap(__float_as_uint(pmax), __float_as_uint(pmax), false, false);
      pmax = fmaxf(__uint_as_float(rr[0]), __uint_as_float(rr[1])); }
    constexpr float C2 = 1.4426950408889634f * SM_SCALE;
    if (__builtin_expect(__all((pmax - m_reg) * SM_SCALE <= THR), 1)) { mn = m_reg; alpha = 1.f; }
    else { mn = fmaxf(m_reg, pmax); alpha = __builtin_amdgcn_exp2f((m_reg - mn) * C2); m_reg = mn; }
    const float mnL = -mn * C2;
#pragma unroll
    for (int r = 0; r < 16; ++r) p0[r] = fmaf(p0[r], C2, mnL);
#pragma unroll
    for (int r = 0; r < 16; ++r) p1[r] = fmaf(p1[r], C2, mnL);
#pragma unroll
    for (int r = 0; r < 16; ++r) p0[r] = __builtin_amdgcn_exp2f(p0[r]);
}
__device__ __forceinline__ void finishSM(f32x16& p0, f32x16& p1, float alpha, float& l_reg, bf16x8& pa0, bf16x8& pa1, bf16x8& pa2, bf16x8& pa3) {
#pragma unroll
    for (int r = 0; r < 16; ++r) p1[r] = __builtin_amdgcn_exp2f(p1[r]);
    float ps = 0;
#pragma unroll
    for (int r = 0; r < 16; ++r) ps += p0[r];
#pragma unroll
    for (int r = 0; r < 16; ++r) ps += p1[r];
    { auto rr = __builtin_amdgcn_permlane32_swap(__float_as_uint(ps), __float_as_uint(ps), false, false);
      ps = __uint_as_float(rr[0]) + __uint_as_float(rr[1]); }
    l_reg = l_reg * alpha + ps;
#define PK4(P, B_, OUT) do { unsigned a0 = cvtpk(P[B_+0], P[B_+1]), a1 = cvtpk(P[B_+2], P[B_+3]);                          \
        unsigned b0 = cvtpk(P[B_+4], P[B_+5]), b1 = cvtpk(P[B_+6], P[B_+7]);                                             \
        auto r0 = __builtin_amdgcn_permlane32_swap(a0, b0, false, false); auto r1 = __builtin_amdgcn_permlane32_swap(a1, b1, false, false); \
        u32x4 w = {r0[0], r1[0], r0[1], r1[1]}; OUT = *reinterpret_cast<bf16x8*>(&w); } while (0)
    PK4(p0, 0, pa0); PK4(p0, 8, pa1); PK4(p1, 0, pa2); PK4(p1, 8, pa3);
#undef PK4
}
__device__ __forceinline__ bf16x8 bias_frag(float x, int hi) {
    const unsigned b1 = f2bf(x); const float r1 = x - __uint_as_float(b1 << 16);
    const unsigned b2 = f2bf(r1); const float r2 = r1 - __uint_as_float(b2 << 16);
    const unsigned b3 = f2bf(r2);
    u32x4 w = {hi ? 0u : (b1 | (b2 << 16)), hi ? 0u : b3, 0u, 0u};
    return *reinterpret_cast<bf16x8*>(&w);
}
template <int KB, int MODE>
__device__ __forceinline__ void qkt(f32x16& p0, f32x16& p1, const char* K_lds, int r32, int hi, const bf16x8* qr, float bz0, float bz1) {
    p0 = f32x16{}; p1 = f32x16{};
    if (MODE == 0) {
        unsigned hm = (unsigned)hi - 1u; asm volatile("" : "+v"(hm));
        u32x4 ow = {hm & 0x3f803f80u, hm & 0x00003f80u, 0u, 0u};
        const bf16x8 ones = *reinterpret_cast<bf16x8*>(&ow);
        p0 = __builtin_amdgcn_mfma_f32_32x32x16_bf16(bias_frag(bz0, hi), ones, p0, 0, 0, 0);
        p1 = __builtin_amdgcn_mfma_f32_32x32x16_bf16(bias_frag(bz1, hi), ones, p1, 0, 0, 0);
    }
    const char* kb[4];
#pragma unroll
    for (int dd = 0; dd < 4; ++dd) kb[dd] = K_lds + KB * SHM_K + KSWZ(r32, (dd * 16 + hi * 8) * 2);
#pragma unroll
    for (int d0 = 0; d0 < 8; ++d0) { const char* a = kb[d0 & 3] + (d0 >> 2) * 128;
        bf16x8 b0 = *reinterpret_cast<const bf16x8*>(a);
        bf16x8 b1 = *reinterpret_cast<const bf16x8*>(a + 32 * 256);
        p0 = __builtin_amdgcn_mfma_f32_32x32x16_bf16(b0, qr[d0], p0, 0, 0, 0);
        p1 = __builtin_amdgcn_mfma_f32_32x32x16_bf16(b1, qr[d0], p1, 0, 0, 0); }
}
template <int VB>
__device__ __forceinline__ void pv_tile(f32x16* o, int vb0, bf16x8 pa0, bf16x8 pa1, bf16x8 pa2, bf16x8 pa3) {
#define TRRD(dst, off) asm volatile("ds_read_b64_tr_b16 %0, %1 offset:%2" : "=&v"(dst) : "v"(vb0), "i"(off) : "memory")
#define PV_D0(d0) do { s16x4 l0, l1, l2, l3, h0, h1, h2, h3; constexpr int b_ = VB * SHM_V + v_rd_off(d0, 0, 0); \
        TRRD(l0, b_); TRRD(h0, b_ + 2048); TRRD(l1, b_ + 4096); TRRD(h1, b_ + 6144); TRRD(l2, b_ + 8192); TRRD(h2, b_ + 10240); TRRD(l3, b_ + 12288); TRRD(h3, b_ + 14336); \
        asm volatile("s_waitcnt lgkmcnt(0)" ::: "memory"); SBAR();   \
        o[d0] = __builtin_amdgcn_mfma_f32_32x32x16_bf16(pa0, (bf16x8){l0[0], l0[1], l0[2], l0[3], h0[0], h0[1], h0[2], h0[3]}, o[d0], 0, 0, 0);   \
        o[d0] = __builtin_amdgcn_mfma_f32_32x32x16_bf16(pa1, (bf16x8){l1[0], l1[1], l1[2], l1[3], h1[0], h1[1], h1[2], h1[3]}, o[d0], 0, 0, 0);   \
        o[d0] = __builtin_amdgcn_mfma_f32_32x32x16_bf16(pa2, (bf16x8){l2[0], l2[1], l2[2], l2[3], h2[0], h2[1], h2[2], h2[3]}, o[d0], 0, 0, 0);   \
        o[d0] = __builtin_amdgcn_mfma_f32_32x32x16_bf16(pa3, (bf16x8){l3[0], l3[1], l3[2], l3[3], h3[0], h3[1], h3[2], h3[3]}, o[d0], 0, 0, 0); } while (0)
    PV_D0(0); PV_D0(1); PV_D0(2); PV_D0(3);
#undef PV_D0
#undef TRRD
}
struct Ref { const bf16_t* Q; const bf16_t* K; const bf16_t* V; bf16_t* O; const float* bias; const unsigned long long* msk; int P0; int NT; };
struct Seam { bf16x8 qr[8]; bf16x8 st_v0, st_v1, st_k0, st_k1; };
template <int MODE> __device__ __forceinline__ size_t qrow_off(int R) { return MODE == 0 ? (size_t)R * 2048 : (size_t)(R >> 3) * 2048 + (size_t)(R & 7) * 128; }
#define ROW(p, k0, rr) ((p) + (size_t)((k0) + (rr)) * PKV + sc)
#define VMW() asm volatile("s_waitcnt vmcnt(0)" ::: "memory")
#define VMWN(n) asm volatile("s_waitcnt vmcnt(%0)" :: "i"(n) : "memory")
#define LD8(p) (*reinterpret_cast<const bf16x8*>(p))
#define SLOAD_H(Kp, Vp, k0) do { S.st_v0 = LD8(ROW(Vp, k0, sr)); S.st_v1 = LD8(ROW(Vp, k0, 32 + sr));              \
                         S.st_k0 = LD8(ROW(Kp, k0, sr)); S.st_k1 = LD8(ROW(Kp, k0, 32 + sr)); } while (0)
#define SWRITE_HK(bf) do { *(bf16x8*)(K_lds + (bf) * SHM_K + kws) = S.st_k0; *(bf16x8*)(K_lds + (bf) * SHM_K + kws + 32 * 256) = S.st_k1; } while (0)
#define SWRITE_HV(bf) do { *(bf16x8*)(V_lds + (bf) * SHM_V + vst0) = S.st_v0; *(bf16x8*)(V_lds + (bf) * SHM_V + vst1) = S.st_v1; } while (0)
#define SWRITE_H(bf) do { SWRITE_HV(bf); SWRITE_HK(bf); } while (0)
template <int MODE>
__device__ __forceinline__ void prime(const Ref& cur, char* lds, Seam& S) {
    constexpr int PKV = MODE == 0 ? 2048 : 512;
    const int tid = threadIdx.x, wid = __builtin_amdgcn_readfirstlane(tid >> 6), lane = tid & 63, r32 = lane & 31, hi = lane >> 5;
    const int sr = tid >> 4, sc = (tid & 15) * 8, kws = KSWZ(sr, sc * 2); char* K_lds = lds + 2 * SHM_V;
    const bf16_t* qp = cur.Q + qrow_off<MODE>(wid * QBLK + r32) + hi * 8;
#pragma unroll
    for (int d0 = 0; d0 < 8; ++d0) S.qr[d0] = LD8(qp + d0 * 16);
    SLOAD_H(cur.K, cur.V, 0); VMW(); SWRITE_HK(0);
    __syncthreads();
}
template <int MODE>
__device__ __forceinline__ void block(const Ref& cur, const Ref& nxt, char* lds, Seam& S) {
    constexpr int PKV = MODE == 0 ? 2048 : 512;
    const int tid = threadIdx.x, wid = __builtin_amdgcn_readfirstlane(tid >> 6), lane = tid & 63, r32 = lane & 31, hi = lane >> 5;
    const int NT = cur.NT;
    const int qlo = cur.P0 + wid * QBLK, qm = qlo + r32 - 4 * hi;
    char* V_lds = lds; char* K_lds = lds + 2 * SHM_V;
    float* ws = (float*)(lds + 2 * SHM_V + 2 * SHM_K) + wid * 64; float* li_l = ws, * al_l = ws + 32;
    float m_reg = -1e30f, l_reg = 0; f32x16 o[4] = {};
    const int sr = tid >> 4, sc = (tid & 15) * 8, vst0 = v_st(sr, sc), vst1 = v_st(32 + sr, sc), kws = KSWZ(sr, sc * 2);
    const int vb0 = (int)(uintptr_t)V_lds + v_rd_base(lane);
    const bf16_t* Kh = cur.K; const bf16_t* Vh = cur.V;
    const unsigned moff = (unsigned)((wid * 4 + (r32 >> 3)) * 64 * 8);
    unsigned long long mk = 0;
#define RESC(a) do { if (__any((a) < 1.f)) { if (hi == 0) al_l[r32] = (a); asm volatile("s_waitcnt lgkmcnt(0)" ::: "memory");              \
                     for (int d_ = 0; d_ < 4; ++d_) for (int r = 0; r < 16; ++r) o[d_][r] *= al_l[crow(r, hi)]; } } while (0)
#define KBASE(t) ((t) * KVBLK)
#define MASKT(P0_, P1_, t) do { if (MODE == 0) { const int kb_ = KBASE(t); if (kb_ + KVBLK - 1 > qlo) mask_causal(P0_, P1_, qm - kb_); } else mask_bits(P0_, P1_, mk, hi); } while (0)
#define MLOAD_(t, off) do { if (MODE == 1) mk = *(const unsigned long long*)((const char*)(cur.msk + (t)) + (off)); } while (0)
#define MLOAD(t) MLOAD_(t, moff)
#define BLOAD(X0, X1, t) do { if (MODE == 0 && !(MK_DBG & 2)) { X0 = cur.bias[KBASE(t) + r32]; X1 = cur.bias[KBASE(t) + 32 + r32]; } } while (0)
#define SEAM_K0() do { if (QPRE) VMWN(8); else VMWN(0); SWRITE_HK(0); SBAR(); } while (0)
    f32x16 pA0, pA1, pB0, pB1; float mnA, mnB, alA, alB; bf16x8 pa0, pa1, pa2, pa3;
    float bz0 = 0.f, bz1 = 0.f;
    BLOAD(bz0, bz1, 0);
    SWRITE_HV(0); SBAR();
    if (NT > 1) SLOAD_H(Kh, Vh, KBASE(1));
    MLOAD(0);
    SBAR(); qkt<0, MODE>(pA0, pA1, K_lds, r32, hi, S.qr, bz0, bz1);
    if (NT > 1) BLOAD(bz0, bz1, 1);
    MASKT(pA0, pA1, 0); partialSM(pA0, pA1, m_reg, mnA, alA);
    if (NT > 1) { VMW(); SWRITE_H(1); }
    __syncthreads();
#define HALF_STEP(PX0, PX1, mnX, alX, PY0, PY1, alY, t, KB, VB, SB) do {                                                      \
        MLOAD(t); SBAR(); qkt<KB, MODE>(PX0, PX1, K_lds, r32, hi, S.qr, bz0, bz1);                                            \
        finishSM(PY0, PY1, alY, l_reg, pa0, pa1, pa2, pa3); SBAR();                                                           \
        if ((t) + 1 < NT) { SLOAD_H(Kh, Vh, KBASE((t) + 1)); BLOAD(bz0, bz1, (t) + 1); SBAR(); }                              \
        pv_tile<VB>(o, vb0, pa0, pa1, pa2, pa3); MASKT(PX0, PX1, (t)); partialSM(PX0, PX1, m_reg, mnX, alX);                  \
        __syncthreads();                                                                                                      \
        if ((t) + 1 < NT) { VMW(); SWRITE_H(SB); }                                                                            \
        RESC(alX); __syncthreads(); } while (0)
    for (int t = 1; t + 1 < NT; t += 2) {
        HALF_STEP(pB0, pB1, mnB, alB, pA0, pA1, alA, t, 1, 0, 0);
        HALF_STEP(pA0, pA1, mnA, alA, pB0, pB1, alB, t + 1, 0, 1, 1);
    }
    const bool even = (NT & 1) == 0;
    constexpr bool QPRE = (MODE == 1);
    int tid2 = tid; asm volatile("" : "+v"(tid2));
    const int lane2 = tid2 & 63, r32e = lane2 & 31, hie = lane2 >> 5, sre = tid2 >> 4, sce = (tid2 & 15) * 8;
    const unsigned moffe = (unsigned)((wid * 4 + (r32e >> 3)) * 64 * 8);
    if (even) { MLOAD_(NT - 1, moffe); SBAR(); qkt<1, MODE>(pB0, pB1, K_lds, r32, hi, S.qr, bz0, bz1); SBAR(); }
    { const bf16_t* vp = nxt.V + (size_t)sre * PKV + sce; const bf16_t* kp = nxt.K + (size_t)sre * PKV + sce;
      S.st_v0 = LD8(vp); S.st_v1 = LD8(vp + (size_t)32 * PKV); S.st_k0 = LD8(kp); S.st_k1 = LD8(kp + (size_t)32 * PKV); SBAR();
      if (QPRE) { const bf16_t* qp = nxt.Q + qrow_off<MODE>(wid * QBLK + r32e) + hie * 8;
#pragma unroll
      for (int d0 = 0; d0 < 8; ++d0) S.qr[d0] = LD8(qp + d0 * 16); } }
    SBAR();
    finishSM(pA0, pA1, alA, l_reg, pa0, pa1, pa2, pa3); SBAR();
    pv_tile<0>(o, vb0, pa0, pa1, pa2, pa3);
    if (even) { MASKT(pB0, pB1, NT - 1); partialSM(pB0, pB1, m_reg, mnB, alB); __syncthreads(); RESC(alB);
        finishSM(pB0, pB1, alB, l_reg, pa0, pa1, pa2, pa3); SBAR(); pv_tile<1>(o, vb0, pa0, pa1, pa2, pa3); }
    SBAR(); SEAM_K0();
    if (hie == 0) li_l[r32e] = l_reg; asm volatile("s_waitcnt lgkmcnt(0)" ::: "memory");
    float rli[16];
#pragma unroll
    for (int r = 0; r < 16; ++r) rli[r] = __builtin_amdgcn_rcpf(li_l[crow(r, hie)]);
#pragma unroll
    for (int r = 0; r < 16; ++r) { bf16_t* orow = cur.O + qrow_off<MODE>(wid * QBLK + crow(r, hie));
#pragma unroll
        for (int d0 = 0; d0 < 4; ++d0) { const float v = o[d0][r] * rli[r];
            const float vn = __shfl_xor(v, 1);
            if ((r32e & 1) == 0) *(unsigned*)(orow + d0 * 32 + r32e) = cvtpk(v, vn); } }
    if (!QPRE) { SBAR(); const bf16_t* qp = nxt.Q + qrow_off<MODE>(wid * QBLK + r32e) + hie * 8;
#pragma unroll
        for (int d0 = 0; d0 < 8; ++d0) S.qr[d0] = LD8(qp + d0 * 16); }
    __syncthreads();
#undef RESC
#undef KBASE
#undef MASKT
#undef MLOAD
#undef MLOAD_
#undef BLOAD
#undef SEAM_K0
#undef HALF_STEP
}
template <int MODE>
__device__ __forceinline__ void sblock(const Ref& cur, char* lds) {
    constexpr int PKV = MODE == 0 ? 2048 : 512;
    const int tid = threadIdx.x, wid = __builtin_amdgcn_readfirstlane(tid >> 6), lane = tid & 63, r32 = lane & 31, hi = lane >> 5;
    const int NT = cur.NT;
    const int qlo = cur.P0 + wid * QBLK, qm = qlo + r32 - 4 * hi;
    char* V_lds = lds; char* K_lds = lds + 2 * SHM_V;
    float* ws = (float*)(lds + 2 * SHM_V + 2 * SHM_K) + wid * 64; float* li_l = ws, * al_l = ws + 32;
    float m_reg = -1e30f, l_reg = 0; f32x16 o[4] = {};
    const int sr = tid >> 4, sc = (tid & 15) * 8, vst0 = v_st(sr, sc), vst1 = v_st(32 + sr, sc), kws = KSWZ(sr, sc * 2);
    const int vb0 = (int)(uintptr_t)V_lds + v_rd_base(lane);
    const unsigned moff = (unsigned)((wid * 4 + (r32 >> 3)) * 64 * 8);
    bf16x8 qr[8];
    { const bf16_t* qp = cur.Q + qrow_off<MODE>(wid * QBLK + r32) + hi * 8;
#pragma unroll
      for (int d0 = 0; d0 < 8; ++d0) qr[d0] = LD8(qp + d0 * 16); }
    Seam S;
    SLOAD_H(cur.K, cur.V, 0);
    for (int t = 0; t < NT; ++t) {
        float bz0 = 0.f, bz1 = 0.f; unsigned long long mk = 0;
        if (MODE == 0 && !(MK_DBG & 2)) { bz0 = cur.bias[t * KVBLK + r32]; bz1 = cur.bias[t * KVBLK + 32 + r32]; }
        if (MODE == 1) mk = *(const unsigned long long*)((const char*)(cur.msk + t) + moff);
        __syncthreads();
        VMW(); SWRITE_H(0);
        if (t + 1 < NT) SLOAD_H(cur.K, cur.V, (t + 1) * KVBLK);
        __syncthreads();
        f32x16 p0, p1; float mn, al; bf16x8 pa0, pa1, pa2, pa3;
        qkt<0, MODE>(p0, p1, K_lds, r32, hi, qr, bz0, bz1);
        if (MODE == 0) { const int kb_ = t * KVBLK; if (kb_ + KVBLK - 1 > qlo) mask_causal(p0, p1, qm - kb_); } else mask_bits(p0, p1, mk, hi);
        partialSM(p0, p1, m_reg, mn, al);
        if (__any(al < 1.f)) { if (hi == 0) al_l[r32] = al; asm volatile("s_waitcnt lgkmcnt(0)" ::: "memory");
            for (int d_ = 0; d_ < 4; ++d_) for (int r = 0; r < 16; ++r) o[d_][r] *= al_l[crow(r, hi)]; }
        finishSM(p0, p1, al, l_reg, pa0, pa1, pa2, pa3);
        pv_tile<0>(o, vb0, pa0, pa1, pa2, pa3);
    }
    if (hi == 0) li_l[r32] = l_reg; asm volatile("s_waitcnt lgkmcnt(0)" ::: "memory");
    float rli[16];
#pragma unroll
    for (int r = 0; r < 16; ++r) rli[r] = __builtin_amdgcn_rcpf(li_l[crow(r, hi)]);
#pragma unroll
    for (int r = 0; r < 16; ++r) { bf16_t* orow = cur.O + qrow_off<MODE>(wid * QBLK + crow(r, hi));
#pragma unroll
        for (int d0 = 0; d0 < 4; ++d0) { const float v = o[d0][r] * rli[r];
            const float vn = __shfl_xor(v, 1);
            if ((r32 & 1) == 0) *(unsigned*)(orow + d0 * 32 + r32) = cvtpk(v, vn); } }
    __syncthreads();
}
#undef ROW
#undef VMW
#undef VMWN
#undef LD8
#undef SLOAD_H
#undef SWRITE_HK
#undef SWRITE_HV
#undef SWRITE_H
}

constexpr int NWAVES = 8;
struct Args { const void* in[25]; float* out; unsigned char* ws; int ph_lo, ph_hi; };
#define GAS __attribute__((address_space(1)))
#define CAS __attribute__((address_space(4)))
struct ArgsD { const GAS void* in[25]; GAS float* out; GAS unsigned char* ws; int ph_lo, ph_hi; };
typedef const CAS ArgsD* ArgsP;
__device__ __forceinline__ ArgsP get_args() { unsigned long long p = (unsigned long long)__builtin_amdgcn_kernarg_segment_ptr(); asm volatile("" : "+s"(p)); return (ArgsP)p; }
struct Frame {
    LAS unsigned char* lds; char* ldsg; volatile LAS unsigned* MISC;
    int tid, lane, wave, vcu, G, gw, NGW;
};
enum { I_X = 0, I_P, I_POS, I_GATTN, I_WIN, I_GCQ, I_WUQ, I_WUQI, I_GKIDX, I_BKIDX, I_GQA, I_GKA, I_BFORGET, I_GQB, I_GKB, I_WUPA, I_WUPB, I_WO, I_GFFN, I_WFG, I_WFU, I_WFD, I_GPLE, I_WPLE, I_WPLEG };

constexpr int TR_STRIP = 64 * 65 * 4;
struct TrItem { const float* W; bf16_t* WT; const float* gain; int ldw, K, n0, k0, scol4; };
__device__ __forceinline__ void tr_load(const TrItem& it, f32x4 (&v)[16], int lane) {
    const float* p = it.W + (size_t)(it.k0 + (lane >> 4)) * it.ldw + (it.scol4 < 0 ? 0 : it.scol4);
#pragma unroll
    for (int q = 0; q < 16; ++q) v[q] = *(const f32x4*)(p + (size_t)(4 * q) * it.ldw);
    if (it.gain) {
#pragma unroll
        for (int q = 0; q < 16; ++q) v[q] = v[q] * it.gain[it.k0 + 4 * q + (lane >> 4)]; }
    else if (it.scol4 < 0) {
#pragma unroll
        for (int q = 0; q < 16; ++q) v[q] = (f32x4){0.f, 0.f, 0.f, 0.f}; }
}
__device__ __forceinline__ void tr_store(const TrItem& it, const f32x4 (&v)[16], LAS float* scr, int lane) {
    const int cb = (lane & 15) * 4;
#pragma unroll
    for (int q = 0; q < 16; ++q) { LAS float* r = scr + (4 * q + (lane >> 4)) * 65 + cb; r[0] = v[q].x; r[1] = v[q].y; r[2] = v[q].z; r[3] = v[q].w; }
    LDS_WAIT(); asm volatile("" ::: "memory");
    const int c = lane & 7;
#pragma unroll
    for (int j = 0; j < 8; ++j) { const int n = (lane >> 3) + 8 * j; const LAS float* sp = scr + (8 * c) * 65 + n;
        u32x4 o; o.x = pk2(sp[0 * 65], sp[1 * 65]); o.y = pk2(sp[2 * 65], sp[3 * 65]); o.z = pk2(sp[4 * 65], sp[5 * 65]); o.w = pk2(sp[6 * 65], sp[7 * 65]);
        *(u32x4*)(it.WT + (size_t)(it.n0 + n) * it.K + it.k0 + 8 * c) = o; }
    LDS_WAIT(); asm volatile("" ::: "memory");
}
__device__ __forceinline__ int win_src_col(int n) {
    if (n < 1632) return n;
    if (n < 1648) return 7776 + (n - 1632);
    if (n < 1792) return -1;
    if (n < 7936) return 1632 + (n - 1792);
    return 7792 + (n - 7936);
}
__device__ __forceinline__ void rms_row_to_bf16(const float* xrow, const float* g, bf16_t* orow, int lane) {
    const f32x4* xr = (const f32x4*)xrow + lane;
    f32x4 v[16]; float s = 0.f;
#pragma unroll
    for (int j = 0; j < 16; ++j) { v[j] = xr[64 * j]; s += (v[j].x * v[j].x + v[j].y * v[j].y) + (v[j].z * v[j].z + v[j].w * v[j].w); }
    const float rstd = 1.0f / sqrtf(wave_sum(s) * (1.f / 4096.f) + EPS);
    const f32x4* gr = (const f32x4*)g + lane;
    unsigned long long* o8 = (unsigned long long*)orow + lane;
#pragma unroll
    for (int j = 0; j < 16; ++j) { const f32x4 gg = gr[64 * j];
        o8[64 * j] = (unsigned long long)pk2(v[j].x * rstd * gg.x, v[j].y * rstd * gg.y) | ((unsigned long long)pk2(v[j].z * rstd * gg.z, v[j].w * rstd * gg.w) << 32); }
}
__device__ __forceinline__ void rms_phase(Frame& F, const float* X, const float* g, bf16_t* O) {
    for (int m = F.gw; m < M; m += F.NGW) rms_row_to_bf16(X + (size_t)m * DM, g, O + (size_t)m * DM, F.lane);
}

constexpr int TJ1 = 252 * 64, TJ3 = 64 * 16, TJPL = 64 * 4, TJUP = 64 * 32, TJO = 64 * 64, TJPG = 64 * 64, TJGU = 344 * 64, TJD = 64 * 172;
constexpr int TR_A = TJ1 + TJ3 + TJPL, TR_B = TR_A + 2 * TJUP + TJO, TR_C = TR_B + TJGU, TR_D = TR_C + TJPG + TJD;
__device__ __forceinline__ void tr_convert(Frame& F, ArgsP a, int lo, int hi, int w0, int nw) {
    LAS float* scr = (LAS float*)(F.lds + F.wave * TR_STRIP);
    auto mk = [&](int it) { TrItem t; t.gain = nullptr; int r = it; const int c4 = (F.lane & 15) * 4;
        if (r < TJ1) { const int kb = r / 252, nb = r % 252; t.W = (const float*)a->in[I_WIN]; t.ldw = INW; t.K = DM; t.WT = (bf16_t*)(a->ws + WS_RB); t.n0 = nb * 64; t.k0 = kb * 64; t.scol4 = win_src_col(nb * 64 + c4); return t; } r -= TJ1;
        if (r < TJ3) { const int kb = r / 64, nb = r % 64; t.W = (const float*)a->in[nb >= 32 ? I_WUQI : I_WUQ]; t.ldw = 2048; t.K = QRANK; t.WT = (bf16_t*)(a->ws + WS_W3T); t.n0 = nb * 64; t.k0 = kb * 64; t.scol4 = (nb & 31) * 64 + c4; return t; } r -= TJ3;
        if (r < TJPL) { const int kb = r / 64, nb = r % 64; t.W = (const float*)a->in[I_WPLE]; t.ldw = DM; t.K = PLE; t.WT = (bf16_t*)(a->ws + WS_WPLET); t.n0 = nb * 64; t.k0 = kb * 64; t.scol4 = nb * 64 + c4; return t; } r -= TJPL;
        if (r < 2 * TJUP) { const bool bb = r >= TJUP; if (bb) r -= TJUP; const int kb = r / 64, nb = r % 64; t.W = (const float*)a->in[bb ? I_WUPB : I_WUPA]; t.ldw = DM; t.K = 2048; t.WT = (bf16_t*)(a->ws + (bb ? WS_WUPB : WS_WUPA)); t.n0 = nb * 64; t.k0 = kb * 64; t.scol4 = nb * 64 + c4; return t; } r -= 2 * TJUP;
        if (r < TJO) { const int kb = r / 64, nb = r % 64; t.W = (const float*)a->in[I_WO]; t.ldw = DM; t.K = DM; t.WT = (bf16_t*)(a->ws + WS_WO); t.n0 = nb * 64; t.k0 = kb * 64; t.scol4 = nb * 64 + c4; return t; } r -= TJO;
        if (r < TJGU) { const int kb = r / 344, nb = r % 344; const int n0 = nb * 64, pn = n0 >> 8, rr = n0 & 255; const bool up = rr >= 128;
            t.W = (const float*)a->in[up ? I_WFU : I_WFG]; t.ldw = DFF; t.K = DM; t.WT = (bf16_t*)(a->ws + WS_WGU); t.gain = (const float*)a->in[I_GFFN]; t.n0 = n0; t.k0 = kb * 64; t.scol4 = pn * 128 + (rr & 127) + c4; return t; } r -= TJGU;
        if (r < TJPG) { const int kb = r / 64, nb = r % 64; t.W = (const float*)a->in[I_WPLEG]; t.ldw = DM; t.K = DM; t.WT = (bf16_t*)(a->ws + WS_WPG); t.gain = (const float*)a->in[I_GPLE]; t.n0 = nb * 64; t.k0 = kb * 64; t.scol4 = nb * 64 + c4; return t; } r -= TJPG;
        { const int kb = r / 64, nb = r % 64; t.W = (const float*)a->in[I_WFD]; t.ldw = DM; t.K = DFF; t.WT = (bf16_t*)(a->ws + WS_WD); t.n0 = nb * 64; t.k0 = kb * 64; t.scol4 = nb * 64 + c4; return t; } };
    f32x4 v[16]; int it = lo + w0;
    if (it < hi) { TrItem cur = mk(it); tr_load(cur, v, F.lane);
        for (;;) { const int nx = it + nw; f32x4 w[16];
#pragma unroll
            for (int q = 0; q < 16; ++q) w[q] = v[q];
            TrItem nxt = cur; const bool more = nx < hi; if (more) { nxt = mk(nx); tr_load(nxt, v, F.lane); }
            tr_store(cur, w, scr, F.lane);
            if (!more) break; cur = nxt; it = nx; } }
}

__device__ __forceinline__ void p0_prologue(Frame& F, ArgsP a) {
    tr_convert(F, a, 0, TR_A, F.gw, F.NGW);
    rms_phase(F, (const float*)a->in[I_X], (const float*)a->in[I_GATTN], (bf16_t*)(a->ws + WS_RA));
    { const f32x4* p4 = (const f32x4*)a->in[I_P]; u32x2* o = (u32x2*)(a->ws + WS_PBF);
      for (int i = (blockIdx.x * NWAVES * 64 + F.tid); i < M * PLE / 4; i += F.G * NWAVES * 64) { const f32x4 v = p4[i]; u32x2 w; w.x = pk2(v.x, v.y); w.y = pk2(v.z, v.w); o[i] = w; } }
    { const int* pos = (const int*)a->in[I_POS]; float* ca = (float*)(a->ws + WS_ROPEA); float* sa = ca + (size_t)M * 64; float* ci = (float*)(a->ws + WS_ROPEI); float* si = ci + (size_t)M * 16;
      const double L2T = 13.287712379549449;
      for (int i = (blockIdx.x * NWAVES * 64 + F.tid); i < M * 80; i += F.G * NWAVES * 64) {
          const int m = i / 80, e = i % 80; const bool isA = e < 64; const int k = isA ? e : e - 64;
          const double inv = exp2(-(double)k * (isA ? L2T / 64.0 : L2T / 16.0));
          double rev = (double)pos[m] * inv * 0.15915494309189535; rev -= floor(rev);
          const float fr = (float)rev; const float c = __builtin_amdgcn_cosf(fr), s = __builtin_amdgcn_sinf(fr);
          if (isA) { ca[(size_t)m * 64 + k] = c; sa[(size_t)m * 64 + k] = s; } else { ci[(size_t)m * 16 + k] = c; si[(size_t)m * 16 + k] = s; } } }
}

__device__ __forceinline__ void p2_fixups(Frame& F, ArgsP a) {
    const int lane = F.lane;
    bf16_t* CQ = (bf16_t*)(a->ws + WS_RC); bf16_t* QB = (bf16_t*)(a->ws + WS_RD); bf16_t* KB = QB + (size_t)M * 2048; bf16_t* KVA = (bf16_t*)(a->ws + WS_KVA);
    const float* MISC = (const float*)(a->ws + WS_MISC);
    const float* ca = (const float*)(a->ws + WS_ROPEA); const float* sa = ca + (size_t)M * 64; const float* ci = (const float*)(a->ws + WS_ROPEI); const float* si = ci + (size_t)M * 16;
    bf16_t* KIDX = (bf16_t*)(a->ws + WS_KIDX); float* WIDX = (float*)(a->ws + WS_WIDX);
    const float* gcq = (const float*)a->in[I_GCQ]; const float* gqb = (const float*)a->in[I_GQB]; const float* gkb = (const float*)a->in[I_GKB]; const float* gka = (const float*)a->in[I_GKA];
    const float* gki = (const float*)a->in[I_GKIDX]; const float* bki = (const float*)a->in[I_BKIDX];
    const f32x4 gca = ((const f32x4*)gcq)[2 * lane], gcb = ((const f32x4*)gcq)[2 * lane + 1], gcc = ((const f32x4*)gcq)[2 * lane + 128], gcd = ((const f32x4*)gcq)[2 * lane + 129];
    const int dl = (lane & 15) * 8; const bool hi = (lane & 8) != 0;
    const f32x4 gka0 = *(const f32x4*)(gka + dl), gka1 = *(const f32x4*)(gka + dl + 4);
    const float gkl = gki[lane], bkl = bki[lane];
    for (int m = F.gw; m < M; m += F.NGW) {
        u32x4* pc = (u32x4*)(CQ + (size_t)m * 1024) + lane;
        u32x4* pa = (u32x4*)(KVA + (size_t)m * 512) + (lane & 31);
        const u32x4 w0 = pc[0], w1 = pc[64];
        const u32x4 wa = pa[0];
        const f32x4 c0 = *(const f32x4*)(ca + (size_t)m * 64 + (dl & 63)), c1 = *(const f32x4*)(ca + (size_t)m * 64 + (dl & 63) + 4);
        f32x4 s0 = *(const f32x4*)(sa + (size_t)m * 64 + (dl & 63)), s1 = *(const f32x4*)(sa + (size_t)m * 64 + (dl & 63) + 4);
        const float xi = MISC[(size_t)m * 256 + lane], wi = MISC[(size_t)m * 256 + 64 + (lane & 31)];
        const float cI = ci[(size_t)m * 16 + (lane & 15)], sI = si[(size_t)m * 16 + (lane & 15)];
        asm volatile("" ::: "memory");
        { f32x4 x0, x1, x2, x3; pg8::unpack8f(w0, x0, x1); pg8::unpack8f(w1, x2, x3);
          float s = 0.f;
#pragma unroll
          for (int j = 0; j < 4; ++j) s += x0[j] * x0[j] + x1[j] * x1[j] + x2[j] * x2[j] + x3[j] * x3[j];
          const float rstd = 1.0f / sqrtf(wave_sum(s) * (1.f / 1024.f) + EPS);
          pc[0] = pg8::pack8f(x0 * rstd * gca, x1 * rstd * gcb); pc[64] = pg8::pack8f(x2 * rstd * gcc, x3 * rstd * gcd); }
        { f32x4 x0, x1; pg8::unpack8f(wa, x0, x1);
          float ss = 0.f;
#pragma unroll
          for (int j = 0; j < 4; ++j) ss += x0[j] * x0[j] + x1[j] * x1[j];
          ss += __shfl_xor(ss, 1); ss += __shfl_xor(ss, 2); ss += __shfl_xor(ss, 4); ss += __shfl_xor(ss, 8);
          const float rstd = 1.0f / sqrtf(ss * (1.f / 128.f) + EPS);
          x0 = x0 * rstd * gka0; x1 = x1 * rstd * gka1;
          if (!hi) { s0 = -s0; s1 = -s1; }
          f32x4 y0, y1;
#pragma unroll
          for (int j = 0; j < 4; ++j) { y0[j] = __shfl_xor(x0[j], 8); y1[j] = __shfl_xor(x1[j], 8); }
          if (lane < 32) pa[0] = pg8::pack8f(x0 * c0 + y0 * s0, x1 * c1 + y1 * s1); }
        { const float mu = wave_sum(xi) * (1.f / 64.f); const float d = xi - mu;
          const float rstd = 1.0f / sqrtf(wave_sum(d * d) * (1.f / 64.f) + EPS);
          const float y = d * rstd * gkl + bkl; const float yo = __shfl_xor(y, 16);
          float r = y; if (lane < 16) r = y * cI - yo * sI; else if (lane < 32) r = y * cI + yo * sI;
          KIDX[((((size_t)(m >> 5) * 4 + ((lane >> 3) & 3)) * 64 + (lane >> 5) * 32 + (m & 31)) << 3) + (lane & 7)] = (bf16_t)f2bf(r);
          if (lane < 32) WIDX[(size_t)m * 32 + lane] = wi * 0.022097086912079608f; }
    }
    if (MK_DBG & 2048) { float* bk = (float*)(a->ws + WS_BIASK); const float* bfp = (const float*)a->in[I_BFORGET];
        for (int i = F.gw * 64 + lane; i < BATCH * NH * SEQ; i += F.NGW * 64) { const int bh = i >> 12, sI = i & 4095, b = bh >> 4, h = bh & 15;
            bk[i] = -100.f * (MISC[((size_t)b * SEQ + sI) * 256 + 96 + h] + bfp[h]) * INV_SM_SCALE; } }
    __syncthreads();
    if (blockIdx.x < BATCH * NH && !(MK_DBG & 2048) && (MK_P2MASK & 16)) {
        const int bh = blockIdx.x, b = bh / NH, h = bh % NH; const float bf = (MK_P2MASK & 32) ? 2.5f : ((const float*)a->in[I_BFORGET])[h];
        LAS float* lf = (LAS float*)(F.lds);
        for (int sIdx = F.tid; sIdx < SEQ; sIdx += NWAVES * 64) { const float x = MISC[((size_t)b * SEQ + sIdx) * 256 + 96 + h] + bf; lf[sIdx] = (MK_DBG & 128) ? x : fminf(x, 0.f) - log1pf(expf(-fabsf(x))); if (MK_DBG & 1024) ((float*)(a->ws + WS_BIASK))[(size_t)bh * SEQ + sIdx] = -100.f * x * INV_SM_SCALE; }
        __syncthreads();
        if (F.wave == 0) {
            float tot = 0.f;
            for (int j = 0; j < 64; ++j) tot += lf[lane * 64 + j];
            float inc = tot;
#pragma unroll
            for (int o = 1; o < 64; o <<= 1) { const float t = __shfl_up(inc, o); if (lane >= o) inc += t; }
            float run = inc - tot;
            float* bk = (float*)(a->ws + WS_BIASK) + (size_t)bh * SEQ + lane * 64;
            for (int j = 0; j < 64; ++j) { if (MK_DBG & 256) run = 100.f * lf[lane * 64 + j]; else run += lf[lane * 64 + j]; if (!(MK_DBG & 1024)) bk[j] = -run * INV_SM_SCALE; }
        }
        __syncthreads();
    }
}

__device__ __forceinline__ void p4_qa_fixup(Frame& F, ArgsP a) {
    const int lane = F.lane, dl = (lane & 15) * 8; bf16_t* QA = (bf16_t*)(a->ws + WS_RA);
    const float* ca = (const float*)(a->ws + WS_ROPEA); const float* sa = ca + (size_t)M * 64; const float* gqa = (const float*)a->in[I_GQA];
    const f32x4 g0 = *(const f32x4*)(gqa + dl), g1 = *(const f32x4*)(gqa + dl + 4); const bool hi = (lane & 8) != 0;
    for (int m = F.gw; m < M; m += F.NGW) { u32x4* p = (u32x4*)(QA + (size_t)m * 2048) + lane;
        u32x4 w[4];
#pragma unroll
        for (int c = 0; c < 4; ++c) w[c] = p[64 * c];
        const f32x4 c0 = *(const f32x4*)(ca + (size_t)m * 64 + (dl & 63)), c1 = *(const f32x4*)(ca + (size_t)m * 64 + (dl & 63) + 4);
        f32x4 s0 = *(const f32x4*)(sa + (size_t)m * 64 + (dl & 63)), s1 = *(const f32x4*)(sa + (size_t)m * 64 + (dl & 63) + 4);
        asm volatile("" ::: "memory");
        if (!hi) { s0 = -s0; s1 = -s1; }
#pragma unroll
        for (int c = 0; c < 4; ++c) { f32x4 x0, x1; pg8::unpack8f(w[c], x0, x1);
            float ss = 0.f;
#pragma unroll
            for (int j = 0; j < 4; ++j) ss += x0[j] * x0[j] + x1[j] * x1[j];
            ss += __shfl_xor(ss, 1); ss += __shfl_xor(ss, 2); ss += __shfl_xor(ss, 4); ss += __shfl_xor(ss, 8);
            const float rstd = 1.0f / sqrtf(ss * (1.f / 128.f) + EPS);
            x0 = x0 * rstd * g0; x1 = x1 * rstd * g1;
            f32x4 y0, y1;
#pragma unroll
            for (int j = 0; j < 4; ++j) { y0[j] = __shfl_xor(x0[j], 8); y1[j] = __shfl_xor(x1[j], 8); }
            p[64 * c] = pg8::pack8f(x0 * c0 + y0 * s0, x1 * c1 + y1 * s1); } }
}

__device__ __forceinline__ int wave_sum_i32(int v) {
    v += __builtin_amdgcn_update_dpp(0, v, 0x111, 0xf, 0xf, true);
    v += __builtin_amdgcn_update_dpp(0, v, 0x112, 0xf, 0xf, true);
    v += __builtin_amdgcn_update_dpp(0, v, 0x114, 0xf, 0xf, true);
    v += __builtin_amdgcn_update_dpp(0, v, 0x118, 0xf, 0xf, true);
    return __builtin_amdgcn_readlane(v, 15) + __builtin_amdgcn_readlane(v, 31) + __builtin_amdgcn_readlane(v, 47) + __builtin_amdgcn_readlane(v, 63);
}
__device__ __forceinline__ unsigned sortable_u(float v) { const unsigned b = __float_as_uint(v); return (b & 0x80000000u) ? ~b : (b | 0x80000000u); }
__device__ __forceinline__ void indexer_query(Frame& F, ArgsP a, int b, int t) {
    const int lane = F.lane, n = lane & 31, kg = lane >> 5;
    const size_t row = (size_t)b * SEQ + t;
    const int nt = (t >> 6) + 1;
    LAS float* sc = (LAS float*)(F.lds + F.wave * 16384);
    const bf16_t* QI = (const bf16_t*)(a->ws + WS_RA) + (size_t)M * 2048; const bf16_t* KIDX = (const bf16_t*)(a->ws + WS_KIDX);
    const float* WIDX = (const float*)(a->ws + WS_WIDX); const float* ci = (const float*)(a->ws + WS_ROPEI); const float* si = ci + (size_t)M * 16;
    unsigned long long* SELM = (unsigned long long*)(a->ws + WS_SELM);
    bf16x8 af[4];
    { const bf16_t* qp = QI + row * 2048 + n * 64 + kg * 32;
#pragma unroll
      for (int s = 0; s < 4; ++s) af[s] = *(const bf16x8*)(qp + 8 * s);
      float x[32];
#pragma unroll
      for (int s = 0; s < 4; ++s)
#pragma unroll
          for (int j = 0; j < 8; ++j) x[8 * s + j] = bf2f((unsigned short)af[s][j]);
      const f32x4* c4 = (const f32x4*)(ci + row * 16); const f32x4* s4 = (const f32x4*)(si + row * 16);
      float y[32];
#pragma unroll
      for (int q = 0; q < 4; ++q) { const f32x4 cc = c4[q], ss = s4[q];
#pragma unroll
          for (int j = 0; j < 4; ++j) { const int i = 4 * q + j; y[i] = x[i] * cc[j] - x[i + 16] * ss[j]; y[i + 16] = x[i + 16] * cc[j] + x[i] * ss[j]; } }
      if (kg == 0) {
#pragma unroll
          for (int s = 0; s < 4; ++s) { u32x4 w; w.x = pk2(y[8 * s], y[8 * s + 1]); w.y = pk2(y[8 * s + 2], y[8 * s + 3]); w.z = pk2(y[8 * s + 4], y[8 * s + 5]); w.w = pk2(y[8 * s + 6], y[8 * s + 7]);
              af[s] = *reinterpret_cast<bf16x8*>(&w); } } }
    typedef float f32x2_t __attribute__((ext_vector_type(2)));
    f32x2_t wp2[8];
    { const float* wp = WIDX + row * 32 + 4 * kg;
#pragma unroll
      for (int j = 0; j < 4; ++j) { const f32x4 w = *(const f32x4*)(wp + 8 * j); wp2[2 * j] = (f32x2_t){w[0], w[1]}; wp2[2 * j + 1] = (f32x2_t){w[2], w[3]}; } }
    const bf16_t* kp = KIDX + (size_t)b * SEQ * 64 + lane * 8;
#define IDX_MMA(BX, cA, cB) do { _Pragma("unroll") for (int s = 0; s < 4; ++s) { cA = __builtin_amdgcn_mfma_f32_32x32x16_bf16(af[s], BX[s], cA, 0, 0, 0); cB = __builtin_amdgcn_mfma_f32_32x32x16_bf16(af[s], BX[4 + s], cB, 0, 0, 0); } } while (0)
#define IDX_SUM(cA, cB, i_) do { f32x2_t aA = {0.f, 0.f}, aB = {0.f, 0.f}; \
        _Pragma("unroll") for (int j = 0; j < 8; ++j) { \
            f32x2_t rA, rB; rA.x = __int_as_float(max(__float_as_int(cA[2 * j]), 0)); rA.y = __int_as_float(max(__float_as_int(cA[2 * j + 1]), 0)); \
            rB.x = __int_as_float(max(__float_as_int(cB[2 * j]), 0)); rB.y = __int_as_float(max(__float_as_int(cB[2 * j + 1]), 0)); \
            aA = __builtin_elementwise_fma(wp2[j], rA, aA); aB = __builtin_elementwise_fma(wp2[j], rB, aB); } \
        const float sA = aA.x + aA.y, sB = aB.x + aB.y; \
        auto rr = __builtin_amdgcn_permlane32_swap(__float_as_uint(sA), __float_as_uint(sB), false, false); \
        sc[(i_) * 64 + lane] = __uint_as_float(sortable_u(__uint_as_float(rr[0]) + __uint_as_float(rr[1]))); } while (0)
#define IDX_LOAD(BX, i_) do { const bf16_t* kn_ = kp + (size_t)(i_) * 4096; \
        _Pragma("unroll") for (int s = 0; s < 4; ++s) { BX[s] = *(const bf16x8*)(kn_ + 512 * s); BX[4 + s] = *(const bf16x8*)(kn_ + 2048 + 512 * s); } } while (0)
    bf16x8 bX[8], bY[8];
    IDX_LOAD(bX, 0); IDX_LOAD(bY, nt > 1 ? 1 : 0);
    for (int i = 0; i < nt; i += 2) {
        f32x16 cA = {}, cB = {}, cC = {}, cD = {};
        IDX_MMA(bX, cA, cB); IDX_LOAD(bX, i + 2 < nt ? i + 2 : nt - 1);
        IDX_MMA(bY, cC, cD); IDX_LOAD(bY, i + 3 < nt ? i + 3 : nt - 1);
        IDX_SUM(cA, cB, i); IDX_SUM(cC, cD, i + 1);
    }
#undef IDX_MMA
#undef IDX_SUM
#undef IDX_LOAD
    unsigned u[64];
#pragma unroll
    for (int i = 0; i < 64; ++i) u[i] = __float_as_uint(sc[i * 64 + lane]);
    asm volatile("" ::: "memory");
#pragma unroll
    for (int i = 0; i < 64; ++i) u[i] = (i < nt) ? u[i] : 0u;
    unsigned mlo = 0u, mhi = 0u;
    if (nt <= TOPK / 64) { if (lane < nt) { mlo = 0xffffffffu; mhi = 0xffffffffu; } }
    else {
        unsigned T = 0u;
        for (int bit = 31; bit >= 0; --bit) {
            const unsigned cand = T | (1u << bit); int cl = 0;
#pragma unroll
            for (int g = 0; g < 8; ++g) { if (g * 8 < nt) {
#pragma unroll
                for (int i = 0; i < 8; ++i) cl += (u[g * 8 + i] >= cand) ? 1 : 0; }
                __builtin_amdgcn_sched_barrier(0); }
            const int c = wave_sum_i32(cl);
            if (c >= TOPK) { T = cand; if (c == TOPK) break; }
        }
        int cgt = 0;
#pragma unroll
        for (int g = 0; g < 8; ++g) { if (g * 8 < nt) {
#pragma unroll
            for (int i = 0; i < 8; ++i) cgt += __popcll(__ballot(u[g * 8 + i] > T)); }
            __builtin_amdgcn_sched_barrier(0); }
        int need = TOPK - cgt;
#pragma unroll
        for (int g = 0; g < 8; ++g) { if (g * 8 < nt) {
#pragma unroll
            for (int i8 = 0; i8 < 8; ++i8) { const int i = g * 8 + i8;
                unsigned long long mk = __ballot(u[i] > T); unsigned long long eq = __ballot(u[i] == T);
                if (eq) { int ce = __popcll(eq);
                    if (ce > need) { int drop = ce - need; while (drop-- > 0) eq &= ~(1ull << (63 - __clzll((long long)eq))); ce = need; }
                    need -= ce; mk |= eq; }
                if (lane == i) { mlo = (unsigned)mk; mhi = (unsigned)(mk >> 32); } } }
            __builtin_amdgcn_sched_barrier(0); }
    }
    SELM[row * 64 + lane] = ((unsigned long long)mhi << 32) | mlo;
}

__device__ __forceinline__ void naive_attn_row(int lane, const bf16_t* q, const bf16_t* K, const bf16_t* V, int pitch, int nk, const float* bias, const unsigned long long* msk, bf16_t* out, LAS float* pl, const float* lfp = nullptr, float bfv = 0.f) {
    u32x4 qv[16];
#pragma unroll
    for (int i = 0; i < 16; ++i) qv[i] = *(const u32x4*)(q + 8 * i);
    float mx = -3.0e38f; float carry = 0.f;
    for (int c = 0; c * 64 < nk; ++c) { const int sk = c * 64 + lane; bool valid = sk < nk; if (msk) valid = valid && ((msk[c] >> lane) & 1ull);
        float fb = 0.f;
        if (lfp) { const float xx = lfp[(size_t)sk * 256] + bfv; float inc = fminf(xx, 0.f) - log1pf(expf(-fabsf(xx)));
            for (int o = 1; o < 64; o <<= 1) { const float tt = __shfl_up(inc, o); if (lane >= o) inc += tt; }
            fb = -(carry + inc) * INV_SM_SCALE; carry += __shfl(inc, 63); }
        float dot = 0.f;
        if (sk < nk) { const u32x4* kr = (const u32x4*)(K + (size_t)sk * pitch);
#pragma unroll
            for (int i = 0; i < 16; ++i) { const u32x4 kv = kr[i];
                dot += bflo(qv[i].x) * bflo(kv.x) + bfhi(qv[i].x) * bfhi(kv.x) + bflo(qv[i].y) * bflo(kv.y) + bfhi(qv[i].y) * bfhi(kv.y)
                     + bflo(qv[i].z) * bflo(kv.z) + bfhi(qv[i].z) * bfhi(kv.z) + bflo(qv[i].w) * bflo(kv.w) + bfhi(qv[i].w) * bfhi(kv.w); } }
        float lg = valid ? (dot + (lfp ? fb : (bias ? bias[sk] : 0.f))) * SM_SCALE : -3.0e38f;
        pl[c * 64 + lane] = lg; mx = fmaxf(mx, lg); }
#pragma unroll
    for (int o = 1; o < 64; o <<= 1) mx = fmaxf(mx, __shfl_xor(mx, o));
    float ls = 0.f;
    for (int c = 0; c * 64 < nk; ++c) { const float lg = pl[c * 64 + lane]; const float p = lg > -1.0e38f ? __expf(lg - mx) : 0.f; pl[c * 64 + lane] = p; ls += p; }
    ls = wave_sum(ls);
    asm volatile("s_waitcnt lgkmcnt(0)" ::: "memory");
    float o0 = 0.f, o1 = 0.f; const int nkr = ((nk + 63) / 64) * 64;
    for (int sk = 0; sk < nkr && sk < nk; ++sk) { const float p = pl[sk]; const unsigned vv = *(const unsigned*)(V + (size_t)sk * pitch + 2 * lane); o0 += p * bflo(vv); o1 += p * bfhi(vv); }
    const float inv = 1.0f / ls;
    *(unsigned*)(out + 2 * lane) = pk2(o0 * inv, o1 * inv);
}
__device__ __forceinline__ void dbg_check_proj(Frame& F, ArgsP a) {
    const int lane = F.lane; LAS float* hv = (LAS float*)(F.lds + F.wave * 16384);
    const float* X_ = (const float*)a->in[I_X]; const float* W = (const float*)a->in[I_WIN]; const float* ga = (const float*)a->in[I_GATTN];
    unsigned* flag = (unsigned*)(a->ws + WS_CTL) + 8;
    const bf16_t* QB = (const bf16_t*)(a->ws + WS_RD); const bf16_t* KB = QB + (size_t)M * 2048; const bf16_t* VB = KB + (size_t)M * 2048; const bf16_t* GT = (const bf16_t*)(a->ws + WS_RG);
    const float* gqb = (const float*)a->in[I_GQB]; const float* gkb = (const float*)a->in[I_GKB];
    if (MK_CHECK & 2) { const bf16_t* W1T = (const bf16_t*)(a->ws + WS_RB);
        for (int it = F.gw; it < 64; it += F.NGW) { const int half = it & 1, n = 7936 + 256 * (it >> 1) + 128 * half + 5 * (it >> 1) % 128; const int src = 7792 + (n - 7936);
            bool bad = false;
            for (int k = lane; k < DM; k += 64) { const unsigned short e = (unsigned short)f2bf(W[(size_t)k * INW + src]); if (e != W1T[(size_t)n * DM + k]) bad = true; }
            if (__any(bad) && lane == 0) atomicOr(flag, half ? 256u : 128u); } }
    for (int smp = F.gw; smp < 256; smp += F.NGW) { const int m = smp * 64 + (smp * 7) % 61;
        float ss = 0.f; for (int k = lane; k < DM; k += 64) { const float v = X_[(size_t)m * DM + k]; ss += v * v; }
        const float rstd = 1.0f / sqrtf(wave_sum(ss) * (1.f / DM) + EPS);
        for (int k = lane; k < DM; k += 64) hv[k] = bf2f((unsigned short)f2bf(X_[(size_t)m * DM + k] * rstd * ga[k]));
        asm volatile("s_waitcnt lgkmcnt(0)" ::: "memory");
#pragma unroll 1
        for (int gI = 0; gI < 6; ++gI) { float a0 = 0.f, a1 = 0.f;
            const int scol = gI == 0 ? 0 : gI == 1 ? 128 : gI == 2 ? 1632 + 256 : gI == 3 ? 1632 + 2048 + 1024 : gI == 4 ? 1632 + 4096 : 1024;
            const float* wp = W + scol + 2 * lane;
#pragma unroll 2
            for (int k = 0; k < DM; ++k) { const float hk = hv[k]; const f32x2 w2 = *(const f32x2*)(wp + (size_t)k * INW); a0 += hk * bf2f((unsigned short)f2bf(w2.x)); a1 += hk * bf2f((unsigned short)f2bf(w2.y)); }
            const float e0 = a0, e1 = a1;
            const bf16_t* gp = gI == 0 ? (const bf16_t*)(a->ws + WS_RC) + (size_t)m * 1024 : gI == 1 ? (const bf16_t*)(a->ws + WS_RC) + (size_t)m * 1024 + 128 : gI == 2 ? QB + (size_t)m * 2048 + 256 : gI == 3 ? KB + (size_t)m * 2048 + 1024 : gI == 4 ? VB + (size_t)m * 2048 : (const bf16_t*)(a->ws + WS_KVA) + (size_t)m * 512;
            const unsigned got = *(const unsigned*)(gp + 2 * lane); const float g0 = bflo(got), g1 = bfhi(got);
            const bool bad = fabsf(g0 - e0) > 0.03f + 0.02f * fabsf(e0) || fabsf(g1 - e1) > 0.03f + 0.02f * fabsf(e1);
            if (__any(bad) && lane == 0) atomicOr(flag, 1u << gI); }
    }
}
__device__ __forceinline__ int snake(int j, int w, int G) { return j * G + ((j & 1) ? (G - 1 - w) : w); }
__device__ __forceinline__ int q_grab(Frame& F, unsigned* head, int& par) {
    if (F.tid == 0) F.MISC[32 + par] = atomicAdd(head, 1u);
    __syncthreads();
    const int v = (int)F.MISC[32 + par]; par ^= 1; return v;
}
__device__ __forceinline__ fa::Ref fox_ref(int L, bf16_t* RD, const float* biasK, float thr, int lane) {
    const int qb = 15 - (L >> 6), bh = L & 63, b = bh >> 4, h = bh & 15; fa::Ref r;
    const size_t base = (size_t)b * SEQ * 2048 + (size_t)h * 128;
    const float* bp = biasK + (size_t)bh * SEQ; const int t0 = qb * 256, nj = qb * 4;
    const float bt = bp[t0], bj = bp[64 * (lane < nj ? lane : 0) + 63];
    const unsigned long long sk = __ballot(lane < nj && (bt - bj) * SM_SCALE > thr);
    const int T0 = sk == ~0ull ? 64 : __builtin_ctzll(~sk);
    r.Q = RD + base + (size_t)qb * 256 * 2048; r.O = RD + base + (size_t)qb * 256 * 2048;
    r.K = RD + (size_t)M * 2048 + base + (size_t)T0 * 64 * 2048; r.V = RD + (size_t)2 * M * 2048 + base + (size_t)T0 * 64 * 2048;
    r.bias = bp + T0 * 64; r.msk = nullptr; r.P0 = t0 - T0 * 64; r.NT = (qb + 1) * 4 - T0; return r;
}
__device__ __forceinline__ fa::Ref dsa_ref(int L, bf16_t* RA, const bf16_t* KVA, const unsigned long long* SELM) {
    const int c = 63 - (L >> 4), r = L & 15, b = r >> 2, g = (r >> 1) & 1, hf = r & 1; const int t0 = c * 64 + hf * 32; fa::Ref q;
    q.Q = RA + ((size_t)b * SEQ + t0) * 2048 + (size_t)g * 8 * 128; q.O = RA + (size_t)M * 2048 + ((size_t)b * SEQ + t0) * 2048 + (size_t)g * 8 * 128;
    q.K = KVA + (size_t)b * SEQ * 512 + (size_t)g * 128; q.V = KVA + (size_t)b * SEQ * 512 + 256 + (size_t)g * 128;
    q.bias = nullptr; q.msk = SELM + ((size_t)b * SEQ + t0) * 64; q.P0 = 0; q.NT = c + 1; return q;
}

constexpr int NPH = 13;
__global__ void __launch_bounds__(NWAVES * 64, 2) mk_fwd(Args args) {
    extern __shared__ __attribute__((aligned(16))) unsigned char lds[];
    Frame F;
    F.lds = (LAS unsigned char*)lds; F.ldsg = (char*)lds;
    F.MISC = (volatile LAS unsigned*)(F.lds + MISC_OFF);
    F.tid = threadIdx.x; F.lane = F.tid & 63; F.wave = __builtin_amdgcn_readfirstlane(F.tid >> 6);
    F.G = gridDim.x; { const int bx = blockIdx.x; F.vcu = (F.G % 8 == 0) ? (bx % 8) * (F.G / 8) + bx / 8 : bx; }
    F.gw = F.vcu * NWAVES + F.wave; F.NGW = F.G * NWAVES;
    ArgsP a = get_args();
    unsigned* ctl = (unsigned*)(a->ws + WS_CTL);
    for (int u = F.tid; u < (LDS_BYTES - LDSCTL_OFF) / 4; u += NWAVES * 64) ((LAS unsigned*)(F.lds + LDSCTL_OFF))[u] = 0u;
    __syncthreads();
    XcdBarrier bar; bar.bar = ctl + CW_BAR; bar.x = 0; bar.st = nullptr;
    if (MK_N_LAUNCHES == 1) bar = xcd_barrier_post(ctl + CW_BAR, F.MISC + 8);
    const int lo = a->ph_lo, hi = a->ph_hi;
#define IN(k) (((MK_PHASE_MASK >> (k)) & 1) && lo <= (k) && (k) < hi)
#define SEAM(k) do { if (IN(k) && IN((k) + 1)) xcd_barrier(bar); } while (0)
#define X ((const float*)a->in[I_X])
#define OUT ((float*)a->out)
#define RA ((bf16_t*)(a->ws + WS_RA))
#define RB ((bf16_t*)(a->ws + WS_RB))
#define RC ((bf16_t*)(a->ws + WS_RC))
#define RD ((bf16_t*)(a->ws + WS_RD))
#define RG ((bf16_t*)(a->ws + WS_RG))
#define KVA ((bf16_t*)(a->ws + WS_KVA))

    if (MK_CHECK && lo == 100) { a = get_args(); dbg_check_proj(F, a); return; }

    if (IN(0)) { a = get_args(); p0_prologue(F, a); } SEAM(0);

    if (IN(1)) { a = get_args();
        pg8::Gemm g{RA, RB, nullptr, nullptr, M, N1, DM}; pg8::StaticOrder S; S.init(M, N1, F.G, (int)blockIdx.x);
        pg8::EpiP1 E{RC, KVA, RD, RG, (float*)(a->ws + WS_MISC), (const float*)a->in[I_GQB], (const float*)a->in[I_GKB], (LAS float*)(F.lds + RING_BYTES)};
        pg8::gemm_phase<pg8::EpiP1, pg8::StaticOrder>(F.lds, g, S, E);
        { const int rem = S.nwg % F.G, c = (int)blockIdx.x;
          if (rem == 0) tr_convert(F, a, TR_A, TR_B, c * NWAVES + F.wave, F.G * NWAVES);
          else if (c >= rem) tr_convert(F, a, TR_A, TR_B, (c - rem) * NWAVES + F.wave, (F.G - rem) * NWAVES); }
    } SEAM(1);

    if (IN(2)) { a = get_args(); if (MK_DBG & 512) { for (int q = 0; q < 600; ++q) __builtin_amdgcn_s_sleep(127); } p2_fixups(F, a); } SEAM(2);

    if (IN(3)) { a = get_args();
        pg8::Gemm g{RC, (const bf16_t*)(a->ws + WS_W3T), nullptr, nullptr, M, 4096, QRANK}; pg8::StaticOrder S; S.init(M, 4096, F.G, (int)blockIdx.x);
        pg8::EpiBf16 E{RA, 2048, 2048, (size_t)M * 2048};
        pg8::gemm_phase<pg8::EpiBf16, pg8::StaticOrder>(F.lds, g, S, E);
        if (MK_NAIVE & 1) { LAS float* pl = (LAS float*)(F.lds + F.wave * 16384); constexpr int NHN = 4; bf16_t* TMP = RB; const float* biasK = (const float*)(a->ws + WS_BIASK);
            for (int it = F.gw; it < M * NHN; it += F.NGW) { const int m = it / NHN, h = it % NHN, b = m / SEQ, t = m % SEQ;
                const bf16_t* qp = RD + (size_t)m * 2048 + h * 128; const size_t kb = (size_t)b * SEQ * 2048 + h * 128;
                naive_attn_row(F.lane, qp, RD + (size_t)M * 2048 + kb, RD + (size_t)2 * M * 2048 + kb, 2048, t + 1, biasK + (size_t)(b * NH + h) * SEQ, nullptr, TMP + (size_t)m * 512 + h * 128, pl,
                    (const float*)(a->ws + WS_MISC) + (size_t)b * SEQ * 256 + 96 + h, ((const float*)a->in[I_BFORGET])[h]); } }
    } SEAM(3);

    if (IN(4)) { a = get_args();
        if (MK_DBG & 8) { for (int u = 135168 / 4 + F.tid; u < LDS_BYTES / 4; u += NWAVES * 64) ((LAS unsigned*)F.lds)[u] = 0u; __syncthreads(); }
        if (MK_DBG & 16) { for (int q = 0; q < 64; ++q) __builtin_amdgcn_s_sleep(64); }
        if (MK_ATTN & 1) {
            const float* biasK = (const float*)(a->ws + WS_BIASK);
            float thr;
            { const float* gq = (const float*)a->in[I_GQB]; const float* gk = (const float*)a->in[I_GKB];
              float mq = fmaxf(fabsf(gq[F.lane]), fabsf(gq[F.lane + 64])), mk_ = fmaxf(fabsf(gk[F.lane]), fabsf(gk[F.lane + 64]));
#pragma unroll
              for (int o = 1; o < 64; o <<= 1) { mq = fmaxf(mq, __shfl_xor(mq, o)); mk_ = fmaxf(mk_, __shfl_xor(mk_, o)); }
              thr = 2.0f * 11.313708499f * 1.03f * mq * mk_ + 96.0f; }
#define mkref(L) fox_ref((L), RD, biasK, thr, F.lane)
            { unsigned* qh = (unsigned*)(a->ws + WS_CTL) + CW_QFOX; int par = 0;
              const int L0 = q_grab(F, qh, par);
              if (L0 < 1024) { fa::Seam S; fa::Ref cur = mkref(L0);
                  fa::prime<0>(cur, F.ldsg, S);
                  for (;;) { const int Ln = q_grab(F, qh, par); const bool has = Ln < 1024; const fa::Ref nxt = has ? mkref(Ln) : cur;
                      fa::block<0>(cur, nxt, F.ldsg, S); if (!has) break; cur = nxt; } } }
#undef mkref
        } else if (!(MK_ATTN & 4)) {
            u32x4* z = (u32x4*)RD; const u32x4 zz = {0u, 0u, 0u, 0u};
            for (size_t i = (size_t)blockIdx.x * 512 + F.tid; i < (size_t)M * 2048 / 8; i += (size_t)F.G * 512) z[i] = zz;
        }
        if (MK_ATTN & 2) {
            const int NR = 2048 / F.G;
            if (MK_DBG & 1) { unsigned long long* sm = (unsigned long long*)(a->ws + WS_SELM);
                for (size_t i = (size_t)blockIdx.x * 512 + F.tid; i < (size_t)M * 64; i += (size_t)F.G * 512) sm[i] = ~0ull; }
            else
            { unsigned* qh = (unsigned*)(a->ws + WS_CTL) + CW_QIDX; int par = 0;
              int L = q_grab(F, qh, par);
              while (L < 2048) { unsigned tok = 0u; if (F.tid == 0) tok = atomicAdd(qh, 1u);
                  { const int c = 63 - (L >> 5), r = L & 31, b = r >> 3, oc = r & 7; indexer_query(F, a, b, c * 64 + oc * 8 + F.wave); }
                  if (F.tid == 0) F.MISC[32 + par] = tok;
                  __syncthreads(); L = (int)F.MISC[32 + par]; par ^= 1; } }
            p4_qa_fixup(F, a);
        }
        if (MK_ATTN & 4) p4_qa_fixup(F, a);
        if (MK_DBG & 32) { const float* bk = (const float*)(a->ws + WS_BIASK);
            for (int it = F.gw; it < M * NH; it += F.NGW) { const int m = it >> 4, h = it & 15, b = m / SEQ, t = m % SEQ;
                const float v = (MK_DBG & 4096) ? ((const float*)a->in[I_BFORGET])[h] : (MK_DBG & 64) ? ((const float*)(a->ws + WS_MISC))[(size_t)m * 256 + 96 + h] : bk[(size_t)(b * NH + h) * SEQ + t] * 1e-3f; *(unsigned*)(RD + (size_t)m * 2048 + h * 128 + 2 * F.lane) = pk2(v, -v); } }
    } SEAM(4);

    if (IN(5)) { a = get_args();
        if (MK_NAIVE & 1) { constexpr int NHN = 4; const bf16_t* TMP = RB;
            for (int it = F.gw; it < M * NHN; it += F.NGW) { const int m = it / NHN, h = it % NHN;
                *(unsigned*)(RD + (size_t)m * 2048 + h * 128 + 2 * F.lane) = *(const unsigned*)(TMP + (size_t)m * 512 + h * 128 + 2 * F.lane); } }
        if (MK_DBG & 4) { for (int u = 135168 / 4 + F.tid; u < LDS_BYTES / 4; u += NWAVES * 64) ((LAS unsigned*)F.lds)[u] = 0u; __syncthreads(); }
        if (MK_ATTN & 2) {
            const unsigned long long* SELM = (const unsigned long long*)(a->ws + WS_SELM);
#define mkref(L) dsa_ref((L), RA, KVA, SELM)
            const int NR = 1024 / F.G;
            if (NR * F.G == 1024) {
                if (MK_NAIVE & 2) { LAS float* pl = (LAS float*)(F.lds + F.wave * 16384);
                    for (int it = F.gw; it < M * 8; it += F.NGW) { const int m = it >> 3, h = it & 7, b = m / SEQ, t = m % SEQ;
                        const bf16_t* kv = KVA + (size_t)b * SEQ * 512;
                        naive_attn_row(F.lane, RA + (size_t)m * 2048 + h * 128, kv, kv + 256, 512, ((t >> 6) + 1) * 64, nullptr, SELM + (size_t)m * 64, RA + (size_t)M * 2048 + (size_t)m * 2048 + h * 128, pl); }
                    __syncthreads();
                    for (int j = 0; j < NR; ++j) { const int L = snake(j, (int)blockIdx.x, F.G); if (((L >> 1) & 1) == 1) { const fa::Ref cur = mkref(L); fa::sblock<1>(cur, F.ldsg); } } }
                else if (MK_SIMPLE) { for (int j = 0; j < NR; ++j) { const fa::Ref cur = mkref(snake(j, (int)blockIdx.x, F.G)); fa::sblock<1>(cur, F.ldsg); } }
                else {
                fa::Seam S; fa::Ref cur = mkref(snake(0, (int)blockIdx.x, F.G));
                fa::prime<1>(cur, F.ldsg, S);
                for (int j = 0; j < NR; ++j) { const fa::Ref nxt = (j + 1 < NR) ? mkref(snake(j + 1, (int)blockIdx.x, F.G)) : cur;
                    fa::block<1>(cur, nxt, F.ldsg, S); cur = nxt; } }
            }
#undef mkref
        } else if (!(MK_ATTN & 4)) {
            u32x4* z = (u32x4*)(RA + (size_t)M * 2048); const u32x4 zz = {0u, 0u, 0u, 0u};
            for (size_t i = (size_t)blockIdx.x * 512 + F.tid; i < (size_t)M * 2048 / 8; i += (size_t)F.G * 512) z[i] = zz;
        }
    } SEAM(5);

    if (IN(6)) { a = get_args();
        pg8::Gemm g{(MK_ATTN & 8) ? RD + (size_t)M * 2048 : RA + (size_t)M * 2048, (const bf16_t*)(a->ws + WS_WUPA), (MK_ATTN & 8) ? RD + (size_t)2 * M * 2048 : RD, (const bf16_t*)(a->ws + WS_WUPB), M, DM, 2048}; pg8::DualOrder S; S.init(M, DM, F.G, (int)blockIdx.x);
        pg8::EpiMerge E{RG, RB};
        pg8::gemm_phase<pg8::EpiMerge, pg8::DualOrder>(F.lds, g, S, E);
    } SEAM(6);

    if (IN(7)) { a = get_args();
        pg8::Gemm g{RB, (const bf16_t*)(a->ws + WS_WO), nullptr, nullptr, M, DM, DM}; pg8::StaticOrder S; S.init(M, DM, F.G, (int)blockIdx.x);
        pg8::EpiResidNorm<false> E{X, (bf16_t*)(a->ws + WS_H2), (float*)(a->ws + WS_SS)};
        pg8::gemm_phase<pg8::EpiResidNorm<false>, pg8::StaticOrder>(F.lds, g, S, E);
        tr_convert(F, a, TR_B, TR_C, F.gw, F.NGW);
    } SEAM(7);

    if (IN(9)) { a = get_args();
        pg8::Gemm g{(const bf16_t*)(a->ws + WS_H2), (const bf16_t*)(a->ws + WS_WGU), nullptr, nullptr, M, 2 * DFF, DM}; pg8::StaticOrder S; S.init(M, 2 * DFF, F.G, (int)blockIdx.x);
        pg8::EpiSwiGLU E{(bf16_t*)(a->ws + WS_ACT), (const float*)(a->ws + WS_SS)};
        pg8::gemm_phase<pg8::EpiSwiGLU, pg8::StaticOrder>(F.lds, g, S, E);
        { const int rem = S.nwg % F.G, c = (int)blockIdx.x;
          if (rem == 0) tr_convert(F, a, TR_C, TR_D, c * NWAVES + F.wave, F.G * NWAVES);
          else if (c >= rem) tr_convert(F, a, TR_C, TR_D, (c - rem) * NWAVES + F.wave, (F.G - rem) * NWAVES); }
    } SEAM(9);

    if (IN(10)) { a = get_args();
        { pg8::Gemm g{(const bf16_t*)(a->ws + WS_ACT), (const bf16_t*)(a->ws + WS_WD), nullptr, nullptr, M, DM, DFF}; pg8::StaticOrder S; S.init(M, DM, F.G, (int)blockIdx.x);
          pg8::EpiResidNorm<true> E{(const bf16_t*)(a->ws + WS_H2), (bf16_t*)(a->ws + WS_H2), (float*)(a->ws + WS_SS) + M};
          pg8::gemm_phase<pg8::EpiResidNorm<true>, pg8::StaticOrder>(F.lds, g, S, E); }
        { pg8::Gemm g{(const bf16_t*)(a->ws + WS_PBF), (const bf16_t*)(a->ws + WS_WPLET), nullptr, nullptr, M, DM, PLE}; pg8::StaticOrder S; S.init(M, DM, F.G, (int)blockIdx.x);
          pg8::EpiBf16 E{(bf16_t*)(a->ws + WS_E), DM, 0, 0};
          pg8::gemm_phase<pg8::EpiBf16, pg8::StaticOrder>(F.lds, g, S, E); }
    } SEAM(10);

    if (IN(12)) { a = get_args();
        pg8::Gemm g{(const bf16_t*)(a->ws + WS_H2), (const bf16_t*)(a->ws + WS_WPG), nullptr, nullptr, M, DM, DM}; pg8::StaticOrder S; S.init(M, DM, F.G, (int)blockIdx.x);
        pg8::EpiPle E{(const bf16_t*)(a->ws + WS_E), (const bf16_t*)(a->ws + WS_H2), OUT, (const float*)(a->ws + WS_SS) + M};
        pg8::gemm_phase<pg8::EpiPle, pg8::StaticOrder>(F.lds, g, S, E);
    }
#undef IN
#undef SEAM
#undef X
#undef OUT
#undef RA
#undef RB
#undef RC
#undef RD
#undef RG
#undef KVA
}

extern "C" void kernel_launch(void* const* d_in, const int* in_sizes, int n_in, void* d_out, int out_size, void* d_ws, size_t ws_size, hipStream_t stream) {
    static int grid = 0;
    if (grid == 0) {
        if (n_in != 25 || in_sizes[0] != M * DM || out_size != M * DM || ws_size < WS_END) {
            fprintf(stderr, "kernel_launch: shape / workspace mismatch (n_in %d, in0 %d, out %d, ws %zu, need %zu); nothing launched\n", n_in, n_in > 0 ? in_sizes[0] : -1, out_size, ws_size, (size_t)WS_END); grid = -1; return; }
        int dev = 0, cus = 0, per_cu = 0;
        if (hipGetDevice(&dev) != hipSuccess || hipDeviceGetAttribute(&cus, hipDeviceAttributeMultiprocessorCount, dev) != hipSuccess) { grid = -1; return; }
        if (hipFuncSetAttribute((const void*)mk_fwd, hipFuncAttributeMaxDynamicSharedMemorySize, LDS_BYTES) != hipSuccess) { fprintf(stderr, "kernel_launch: hipFuncSetAttribute failed\n"); grid = -1; return; }
        if (hipOccupancyMaxActiveBlocksPerMultiprocessor(&per_cu, (const void*)mk_fwd, NWAVES * 64, LDS_BYTES) != hipSuccess || per_cu < 1)
            fprintf(stderr, "kernel_launch: occupancy query reports %d workgroups per CU\n", per_cu);
        (void)hipGetLastError();
        grid = cus;
        if (grid != 256) fprintf(stderr, "kernel_launch: %d CUs (built for 256)\n", grid);
    }
    if (grid < 0) return;
    if (hipMemsetAsync((char*)d_ws + WS_CTL, 0, CTL_ZERO_BYTES, stream) != hipSuccess) return;
    Args a{};
    for (int i = 0; i < 25; ++i) a.in[i] = d_in[i];
    a.out = (float*)d_out; a.ws = (unsigned char*)d_ws;
    if (MK_N_LAUNCHES == 1) { a.ph_lo = 0; a.ph_hi = NPH; hipLaunchKernelGGL(mk_fwd, dim3(grid), dim3(NWAVES * 64), LDS_BYTES, stream, a); }
    else for (int li = 0; li < NPH; ++li) { a.ph_lo = li; a.ph_hi = li + 1; hipLaunchKernelGGL(mk_fwd, dim3(grid), dim3(NWAVES * 64), LDS_BYTES, stream, a);
        if (MK_CHECK && li == 1) { a.ph_lo = 100; a.ph_hi = 101; hipLaunchKernelGGL(mk_fwd, dim3(grid), dim3(NWAVES * 64), LDS_BYTES, stream, a); } }
}
```

```cpp
#include <hip/hip_runtime.h>
#include <cstdio>
#include <cstdint>

#ifndef MK_N_LAUNCHES
#define MK_N_LAUNCHES 1
#endif
#ifndef MK_PHASE_MASK
#define MK_PHASE_MASK 0x1fff
#endif

#ifndef MK_P2MASK
#define MK_P2MASK 31
#endif
#ifndef MK_CHECK
#define MK_CHECK 0
#endif
#ifndef MK_NAIVE
#define MK_NAIVE 0
#endif
#ifndef MK_SIMPLE
#define MK_SIMPLE 0
#endif
#ifndef MK_DBG
#define MK_DBG 0
#endif
#ifndef MK_ATTN
#define MK_ATTN 3
#endif

#define LAS __attribute__((address_space(3)))
typedef unsigned short bf16_t;
typedef short bf16x8 __attribute__((ext_vector_type(8)));
typedef short s16x4 __attribute__((ext_vector_type(4)));
typedef float f32x2 __attribute__((ext_vector_type(2)));
typedef float f32x4 __attribute__((ext_vector_type(4)));
typedef float f32x16 __attribute__((ext_vector_type(16)));
typedef unsigned u32x2 __attribute__((ext_vector_type(2)));
typedef unsigned u32x4 __attribute__((ext_vector_type(4)));

constexpr int BATCH = 4, SEQ = 4096, DM = 4096, M = BATCH * SEQ;
constexpr int NH = 16, HD = 128, QRANK = 1024, NIH = 32, IDIM = 64, DFF = 11008, PLE = 256, TOPK = 256;
constexpr int INW = 15984;
constexpr int N1 = 16128;
constexpr float EPS = 1e-6f;
constexpr float SM_SCALE = 0.08838834764831845f;
constexpr float INV_SM_SCALE = 11.313708498984761f;

constexpr size_t MiB = 1u << 20;
constexpr size_t WS_CTL = 0, CTL_ZERO_BYTES = 1 * MiB;
constexpr size_t WS_W3T = 1 * MiB;
constexpr size_t WS_WPLET = WS_W3T + 8 * MiB;
constexpr size_t WS_WUPA = WS_WPLET + 2 * MiB;
constexpr size_t WS_WUPB = WS_WUPA + 16 * MiB;
constexpr size_t WS_WO = WS_WUPB + 16 * MiB;
constexpr size_t WS_ROPEA = WS_WO + 32 * MiB;
constexpr size_t WS_ROPEI = WS_ROPEA + 8 * MiB;
constexpr size_t WS_KIDX = WS_ROPEI + 2 * MiB;
constexpr size_t WS_WIDX = WS_KIDX + 2 * MiB;
constexpr size_t WS_BIASK = WS_WIDX + 2 * MiB;
constexpr size_t WS_SELM = WS_BIASK + 1 * MiB;
constexpr size_t WS_PBF = WS_SELM + 8 * MiB;
constexpr size_t WS_KVA = WS_PBF + 8 * MiB;
constexpr size_t WS_MISC = WS_KVA + 16 * MiB;
constexpr size_t WS_RA = WS_MISC + 16 * MiB;
constexpr size_t WS_RB = WS_RA + 128 * MiB;
constexpr size_t WS_RC = WS_RB + 126 * MiB;
constexpr size_t WS_RD = WS_RC + 32 * MiB;
constexpr size_t WS_RG = WS_RD + 192 * MiB;
constexpr size_t WS_WPG = WS_RG + 256 * MiB;
constexpr size_t WS_END = WS_WPG + 32 * MiB;
constexpr size_t WS_ACT = WS_RA;
constexpr size_t WS_WGU = WS_ACT + 344 * MiB;
constexpr size_t WS_WD = WS_WGU + 172 * MiB;
constexpr size_t WS_H2 = WS_RG + 128 * MiB;
constexpr size_t WS_E = WS_WGU;
constexpr size_t WS_SS = WS_CTL + 512 * 1024;
static_assert(WS_RB - WS_RA == (size_t)M * DM * 2 && WS_RC - WS_RB >= (size_t)N1 * DM * 2 && WS_RD - WS_RC == (size_t)M * QRANK * 2, "ws map");
static_assert(WS_RG - WS_RD == (size_t)3 * M * 2048 * 2 && WS_WGU >= WS_RD + (size_t)M * 2048 * 2 * 0 && WS_WD + 86 * MiB <= WS_H2 && WS_END <= 1024 * MiB, "ws map 2");
static_assert(WS_ACT + (size_t)M * DFF * 2 <= WS_WGU, "act vs WGU");
constexpr int CW_BAR = 4096;
constexpr int CW_QFOX = 8192, CW_QIDX = 8193;

constexpr int RING_BYTES = 131072;
constexpr int LDS_BYTES = 147456;
constexpr int LDSCTL_OFF = LDS_BYTES - 1024, MISC_OFF = LDSCTL_OFF + 320;

#define LDS_WAIT() asm volatile("s_waitcnt lgkmcnt(0)" ::: "memory")
#define VM_WAIT() asm volatile("s_waitcnt vmcnt(0)" ::: "memory")
__device__ __forceinline__ unsigned f2bf(float f) { unsigned u = __builtin_bit_cast(unsigned, f); return (u + 0x7fffu + ((u >> 16) & 1u)) >> 16; }
__device__ __forceinline__ unsigned pk2(float lo, float hi) { return f2bf(lo) | (f2bf(hi) << 16); }
__device__ __forceinline__ float bf2f(unsigned short b) { return __builtin_bit_cast(float, (unsigned)b << 16); }
__device__ __forceinline__ float bflo(unsigned w) { return __builtin_bit_cast(float, w << 16); }
__device__ __forceinline__ float bfhi(unsigned w) { return __builtin_bit_cast(float, w & 0xffff0000u); }
__device__ __forceinline__ unsigned cvtpk(float lo, float hi) { unsigned r; asm volatile("v_cvt_pk_bf16_f32 %0, %1, %2" : "=v"(r) : "v"(lo), "v"(hi)); return r; }
__device__ __forceinline__ float sigmoidf_(float x) { return __builtin_amdgcn_rcpf(1.0f + __builtin_amdgcn_exp2f(-1.4426950408889634f * x)); }
__device__ __forceinline__ float wave_sum(float v) {
#pragma unroll
    for (int o = 1; o < 64; o <<= 1) v += __shfl_xor(v, o);
    return v;
}

#define XB_TMO      128
#define XB_XCNT(j)  (256  + 64 * (j))
#define XB_XSUB(j)  (1280 + 64 * (j))
#define XB_XGEN(j)  (2304 + 64 * (j))
#define XB_TOP      3328
#define XB_TOPGEN   3392
#define XCD_BAR_WORDS 3456
#define XB_SPIN_CAP (1u << 18)
__device__ __forceinline__ unsigned xb_ld(unsigned* p)              { return __hip_atomic_load(p, __ATOMIC_RELAXED, __HIP_MEMORY_SCOPE_AGENT); }
__device__ __forceinline__ unsigned xb_add(unsigned* p, unsigned v) { return __hip_atomic_fetch_add(p, v, __ATOMIC_RELAXED, __HIP_MEMORY_SCOPE_AGENT); }
__device__ __forceinline__ unsigned xb_xcc_id() { return (unsigned)__builtin_amdgcn_s_getreg((3 << 11) | 20) & 0xFu; }
#define XB_SPIN(cond, bar) do { unsigned _sp = 0; while (cond) { __builtin_amdgcn_s_sleep(1); \
    if ((++_sp & 255u) == 0u) { if (xb_ld(&(bar)[XB_TMO])) break; if (_sp > XB_SPIN_CAP) { atomicAdd(&(bar)[XB_TMO], 1u); break; } } } } while (0)
struct XcdBarrier { unsigned* bar; unsigned x; volatile LAS unsigned* st; };
__device__ __forceinline__ XcdBarrier xcd_barrier_post(unsigned* bar, volatile LAS unsigned* st) {
    XcdBarrier b; b.bar = bar; b.x = xb_xcc_id(); b.st = st;
    if (threadIdx.x == 0) (void)xb_add(&bar[XB_XCNT(b.x)], 1u);
    return b;
}
__device__ __forceinline__ void xcd_barrier_complete(unsigned* bar, unsigned x, unsigned& nloc, unsigned& nx) {
    const unsigned G = gridDim.x * gridDim.y * gridDim.z;
    unsigned sum, cnt, mine, sp = 0u;
    for (;;) {
        sum = 0u; cnt = 0u; mine = 0u;
#pragma unroll
        for (unsigned j = 0; j < 16; ++j) { const unsigned c = xb_ld(&bar[XB_XCNT(j)]); sum += c; cnt += (c > 0u) ? 1u : 0u; mine = (j == x) ? c : mine; }
        if (sum == G) break;
        __builtin_amdgcn_s_sleep(1);
        if ((++sp & 255u) == 0u) { if (xb_ld(&bar[XB_TMO])) break; if (sp > XB_SPIN_CAP) { atomicAdd(&bar[XB_TMO], 1u); break; } }
    }
    nloc = mine > 0u ? mine : 1u; nx = cnt > 0u ? cnt : 1u;
}
__device__ __forceinline__ void xcd_barrier(const XcdBarrier& b) {
    asm volatile("s_waitcnt vmcnt(0)" ::: "memory");
    __syncthreads();
    if (threadIdx.x == 0) {
        unsigned* bar = b.bar;
        __builtin_amdgcn_s_waitcnt(0);
        unsigned nloc = b.st[0], nx = b.st[1];
        if (nloc == 0u) { xcd_barrier_complete(bar, b.x, nloc, nx); b.st[0] = nloc; b.st[1] = nx; }
        const unsigned old = xb_add(&bar[XB_XSUB(b.x)], 1u);
        const unsigned gen = old / nloc;
        if (old + 1u == (gen + 1u) * nloc) {
            __builtin_amdgcn_fence(__ATOMIC_RELEASE, "agent");
            asm volatile("s_waitcnt vmcnt(0)" ::: "memory");
            const unsigned og = xb_add(&bar[XB_TOP], 1u);
            const unsigned tg = og / nx;
            if (og + 1u == (tg + 1u) * nx) xb_add(&bar[XB_TOPGEN], 1u);
            else XB_SPIN(xb_ld(&bar[XB_TOPGEN]) == tg, bar);
            __builtin_amdgcn_fence(__ATOMIC_ACQUIRE, "agent");
            xb_add(&bar[XB_XGEN(b.x)], 1u);
            asm volatile("s_waitcnt vmcnt(0)" ::: "memory");
        } else {
            XB_SPIN(xb_ld(&bar[XB_XGEN(b.x)]) == gen, bar);
            __builtin_amdgcn_fence(__ATOMIC_ACQUIRE, "agent");
            asm volatile("s_waitcnt vmcnt(0)" ::: "memory");
        }
    }
    __syncthreads();
}

namespace pg8 {
constexpr int BM = 256, BK = 64, HALF = 128, HTB = HALF * BK * 2, STAGE_BYTES = 8 * HTB, NXCD = 8, WGM = 8;
__host__ __device__ __forceinline__ int lds_byte(int r, int c) { const int st = (r >> 4) * 2 + (c >> 5), rr = r & 15, cc = c & 31, ob = rr * 64 + cc * 2; return st * 1024 + (ob ^ (((ob >> 9) & 1) << 5)); }
__host__ __device__ __forceinline__ void stage_rc(int b, int& R, int& C) { const int st = b / 1024, sb = b % 1024, swz = sb ^ (((sb >> 9) & 1) << 5); R = (st >> 1) * 16 + swz / 64; C = (st & 1) * 32 + (swz % 64) / 2; }
__host__ __device__ __forceinline__ int perm32(int rho) { const int n = rho >> 4, i = rho & 15; return 8 * (i >> 2) + 4 * n + (i & 3); }

struct Unit { int pm, pn, z; };
struct Gemm { const bf16_t* A; const bf16_t* Bt; const bf16_t* A2; const bf16_t* Bt2; int M, N, K; };

struct StaticOrder {
    int nM, nN, nwg, G, c;
    __host__ __device__ void init(int M_, int N_, int G_, int c_) { nM = M_ / BM; nN = N_ / BM; nwg = nM * nN; G = G_; c = c_; }
    __host__ __device__ bool next(int i, Unit& u) const {
        const long L = (long)i * G + c; if (L >= nwg) return false;
        int wgid = (int)L; { const int q = nwg / NXCD, r = nwg % NXCD, xcd = wgid % NXCD, off = wgid / NXCD; wgid = (xcd < r ? xcd * (q + 1) : r * (q + 1) + (xcd - r) * q) + off; }
        const int nig = WGM * nN, gid = wgid / nig, fm = gid * WGM, gsz = (nM - fm) < WGM ? (nM - fm) : WGM;
        u.pm = fm + ((wgid % nig) % gsz); u.pn = (wgid % nig) / gsz; u.z = 0; return true;
    }
    __device__ __forceinline__ void a_ready(const Unit&) const {}
    __device__ __forceinline__ void done(const Unit&) const {}
};
struct DualOrder : StaticOrder {
    __host__ __device__ bool next(int i, Unit& u) const { const bool ok = StaticOrder::next(i >> 1, u); u.z = i & 1; return ok; }
};

template <class Epi, class Sched, bool ALIGN_EPI = true, bool SP2 = true>
__device__ __forceinline__ void gemm_phase(LAS unsigned char* lds, const Gemm g, const Sched& S, const Epi& E) {
    const int tid = threadIdx.x, wid = __builtin_amdgcn_readfirstlane(tid >> 6), lane = tid & 63, wr = wid >> 2, wc = wid & 3, fr = lane & 15, fq = lane >> 4;
    const int K = g.K, nt = K / BK;
    unsigned voffA[2], voffB[2];
#pragma unroll
    for (int i = 0; i < 2; ++i) { int R, C; stage_rc(tid * 16 + i * 8192, R, C); const int Rb = Epi::PERM ? ((R & ~31) + perm32(R & 31)) : R;
        voffA[i] = (unsigned)(R * K + C) * 2u; voffB[i] = (unsigned)(Rb * K + C) * 2u; }
    const size_t kstep = (size_t)(BK * 2);
    const size_t hstep = (size_t)HALF * K * 2;
    const size_t tstep = 2 * hstep;
    const unsigned ldsw = (unsigned)wid * 1024u;
    const int aoff = lds_byte(wr * 64 + fr, fq * 8), boff = lds_byte(wc * 32 + fr, fq * 8);
#define PG8_SA(b, h) (((b) * 2 + (h)) * HTB)
#define PG8_SB(b, h) ((4 + (b) * 2 + (h)) * HTB)
#define PG8_STAGE(bufoff, gbase, voff) do { _Pragma("unroll") for (int _i = 0; _i < 2; ++_i) \
        __builtin_amdgcn_global_load_lds((const unsigned*)((const char*)(gbase) + (voff)[_i]), (LAS unsigned*)(lds + (bufoff) + ldsw + _i * 8192), 16, 0, 0); } while (0)
#define PG8_LDA(dst, b, h) do { _Pragma("unroll") for (int m = 0; m < 4; ++m) _Pragma("unroll") for (int k = 0; k < 2; ++k) dst[m][k] = *(const LAS bf16x8*)(lds + PG8_SA(b, h) + aoff + m * 2048 + k * 1024); } while (0)
#define PG8_LDB(dst, b, h) do { _Pragma("unroll") for (int n = 0; n < 2; ++n) _Pragma("unroll") for (int k = 0; k < 2; ++k) dst[n][k] = *(const LAS bf16x8*)(lds + PG8_SB(b, h) + boff + n * 2048 + k * 1024); } while (0)
#define PG8_MMA(ai, bj, At, Bt) do { __builtin_amdgcn_s_setprio(1); _Pragma("unroll") for (int m = 0; m < 4; ++m) _Pragma("unroll") for (int n = 0; n < 2; ++n) _Pragma("unroll") for (int k = 0; k < 2; ++k) \
        acc[ai][bj][m][n] = __builtin_amdgcn_mfma_f32_16x16x32_bf16(Bt[n][k], At[m][k], acc[ai][bj][m][n], 0, 0, 0); __builtin_amdgcn_s_setprio(0); } while (0)
#define PG8_WAIT_V(n) asm volatile("s_waitcnt vmcnt(" #n ")" ::: "memory")
#define PG8_WAIT_L(n) asm volatile("s_waitcnt lgkmcnt(" #n ")" ::: "memory")
#define PG8_BAR __builtin_amdgcn_s_barrier()
#define PG8_SCHED __builtin_amdgcn_sched_barrier(0)
#define PG8_ABASE(u) ((const char*)((u).z ? g.A2 : g.A) + (size_t)(u).pm * tstep)
#define PG8_BBASE(u) ((const char*)((u).z ? g.Bt2 : g.Bt) + (size_t)(u).pn * tstep)
    Unit cur, nxt; int ui = 0;
    if (!S.next(0, cur)) return;
    f32x4 acc[2][2][4][2];
#pragma unroll
    for (int a = 0; a < 2; ++a)
#pragma unroll
        for (int b = 0; b < 2; ++b)
#pragma unroll
            for (int m = 0; m < 4; ++m)
#pragma unroll
                for (int n = 0; n < 2; ++n) acc[a][b][m][n] = (f32x4){0.f, 0.f, 0.f, 0.f};
    bf16x8 At[4][2], B0[2][2], B1[2][2];
    const char* cA = PG8_ABASE(cur); const char* cB = PG8_BBASE(cur);
    S.a_ready(cur);
    if constexpr (SP2) {
        PG8_STAGE(PG8_SB(0, 0), cB, voffB); PG8_STAGE(PG8_SB(0, 1), cB + hstep, voffB); PG8_STAGE(PG8_SA(0, 0), cA, voffA); PG8_STAGE(PG8_SA(0, 1), cA + hstep, voffA);
        if (wr == 1) PG8_BAR;
        PG8_WAIT_V(2); PG8_BAR;
        PG8_STAGE(PG8_SB(1, 0), cB + kstep, voffB); PG8_STAGE(PG8_SA(1, 0), cA + kstep, voffA); PG8_STAGE(PG8_SB(1, 1), cB + hstep + kstep, voffB);
        PG8_WAIT_V(6); PG8_BAR;
    } else {
        PG8_STAGE(PG8_SB(0, 0), cB, voffB); PG8_STAGE(PG8_SA(0, 0), cA, voffA); PG8_STAGE(PG8_SB(0, 1), cB + hstep, voffB); PG8_STAGE(PG8_SA(0, 1), cA + hstep, voffA);
        if (wr == 1) PG8_BAR;
        PG8_WAIT_V(4); PG8_BAR;
        PG8_STAGE(PG8_SB(1, 0), cB + kstep, voffB); PG8_STAGE(PG8_SA(1, 0), cA + kstep, voffA); PG8_STAGE(PG8_SB(1, 1), cB + hstep + kstep, voffB);
        PG8_WAIT_V(6); PG8_BAR;
    }
    for (;;) {
        const bool has_next = S.next(ui + 1, nxt);
        const char* nA = has_next ? PG8_ABASE(nxt) : cA; const char* nB = has_next ? PG8_BBASE(nxt) : cB;
        for (int t = 0; t < nt; t += 2) {
            const bool last = (t == nt - 2);
            const char* a1 = cA + (size_t)(t + 1) * kstep;
            const char* a2 = last ? nA : cA + (size_t)(t + 2) * kstep; const char* b2 = last ? nB : cB + (size_t)(t + 2) * kstep;
            const char* a3 = a2 + kstep; const char* b3 = b2 + kstep;
            if (last && has_next) S.a_ready(nxt);
            if constexpr (SP2) {
            PG8_LDB(B0, 0, 0); PG8_LDB(B1, 0, 1); PG8_SCHED; PG8_LDA(At, 0, 0); PG8_STAGE(PG8_SA(1, 1), a1 + hstep, voffA);
            PG8_WAIT_V(8); PG8_WAIT_L(0); PG8_BAR; PG8_MMA(0, 0, At, B0); PG8_MMA(0, 1, At, B1); PG8_BAR; PG8_SCHED;
            PG8_LDA(At, 0, 1); PG8_STAGE(PG8_SB(0, 0), b2, voffB); PG8_STAGE(PG8_SB(0, 1), b2 + hstep, voffB); PG8_STAGE(PG8_SA(0, 0), a2, voffA);
            PG8_WAIT_V(8); PG8_WAIT_L(0); PG8_BAR; PG8_MMA(1, 0, At, B0); PG8_MMA(1, 1, At, B1); PG8_BAR; PG8_SCHED;
            PG8_LDB(B0, 1, 0); PG8_LDB(B1, 1, 1); PG8_SCHED; PG8_LDA(At, 1, 0); PG8_STAGE(PG8_SA(0, 1), a2 + hstep, voffA);
            PG8_WAIT_V(8); PG8_WAIT_L(0); PG8_BAR; PG8_MMA(0, 0, At, B0); PG8_MMA(0, 1, At, B1); PG8_BAR; PG8_SCHED;
            PG8_LDA(At, 1, 1); PG8_STAGE(PG8_SB(1, 0), b3, voffB); PG8_STAGE(PG8_SB(1, 1), b3 + hstep, voffB); PG8_STAGE(PG8_SA(1, 0), a3, voffA);
            PG8_WAIT_V(8); PG8_WAIT_L(0); PG8_BAR; PG8_MMA(1, 0, At, B0); PG8_MMA(1, 1, At, B1); PG8_BAR; PG8_SCHED;
            } else {
            PG8_LDB(B0, 0, 0); PG8_SCHED; PG8_LDA(At, 0, 0); PG8_STAGE(PG8_SA(1, 1), a1 + hstep, voffA);
            PG8_WAIT_L(8); PG8_BAR; PG8_WAIT_L(0); PG8_MMA(0, 0, At, B0); PG8_BAR; PG8_SCHED;
            PG8_LDB(B1, 0, 1); PG8_STAGE(PG8_SB(0, 0), b2, voffB);
            PG8_BAR; PG8_WAIT_L(0); PG8_MMA(0, 1, At, B1); PG8_BAR;
            PG8_LDA(At, 0, 1); PG8_STAGE(PG8_SA(0, 0), a2, voffA);
            PG8_BAR; PG8_WAIT_L(0); PG8_MMA(1, 0, At, B0); PG8_BAR; PG8_SCHED;
            PG8_STAGE(PG8_SB(0, 1), b2 + hstep, voffB);
            PG8_WAIT_V(6); PG8_BAR; PG8_MMA(1, 1, At, B1); PG8_BAR;
            PG8_LDB(B0, 1, 0); PG8_SCHED; PG8_LDA(At, 1, 0); PG8_STAGE(PG8_SA(0, 1), a2 + hstep, voffA);
            PG8_WAIT_L(8); PG8_BAR; PG8_WAIT_L(0); PG8_MMA(0, 0, At, B0); PG8_BAR; PG8_SCHED;
            PG8_LDB(B1, 1, 1); PG8_STAGE(PG8_SB(1, 0), b3, voffB);
            PG8_BAR; PG8_WAIT_L(0); PG8_MMA(0, 1, At, B1); PG8_BAR;
            PG8_LDA(At, 1, 1); PG8_STAGE(PG8_SA(1, 0), a3, voffA);
            PG8_BAR; PG8_WAIT_L(0); PG8_MMA(1, 0, At, B0); PG8_BAR; PG8_SCHED;
            PG8_STAGE(PG8_SB(1, 1), b3 + hstep, voffB);
            PG8_WAIT_V(6); PG8_BAR; PG8_MMA(1, 1, At, B1); PG8_BAR;
            }
        }
        if constexpr (ALIGN_EPI) { if (wr == 0) PG8_BAR; }
        E(acc, cur, wr, wc, fr, fq);
        if (!has_next) break;
#pragma unroll
        for (int a = 0; a < 2; ++a)
#pragma unroll
            for (int b = 0; b < 2; ++b)
#pragma unroll
                for (int m = 0; m < 4; ++m)
#pragma unroll
                    for (int n = 0; n < 2; ++n) acc[a][b][m][n] = (f32x4){0.f, 0.f, 0.f, 0.f};
        cur = nxt; cA = nA; cB = nB; ++ui;
        if constexpr (ALIGN_EPI) { if (wr == 1) PG8_BAR; }
    }
    PG8_WAIT_V(0);
    if constexpr (!ALIGN_EPI) { if (wr == 0) PG8_BAR; }
    PG8_BAR;
#undef PG8_SA
#undef PG8_SB
#undef PG8_STAGE
#undef PG8_LDA
#undef PG8_LDB
#undef PG8_MMA
#undef PG8_WAIT_V
#undef PG8_WAIT_L
#undef PG8_BAR
#undef PG8_SCHED
#undef PG8_ABASE
#undef PG8_BBASE
}

#define EPI_ROWS_BEGIN _Pragma("unroll") for (int ai = 0; ai < 2; ++ai) _Pragma("unroll") for (int m = 0; m < 4; ++m) { const size_t row = (size_t)(u.pm * BM + ai * HALF + wr * 64 + m * 16 + fr);
#define EPI_ROWS_END }
__device__ __forceinline__ u32x4 pack8f(f32x4 a, f32x4 b) { u32x4 w; w.x = cvtpk(a[0], a[1]); w.y = cvtpk(a[2], a[3]); w.z = cvtpk(b[0], b[1]); w.w = cvtpk(b[2], b[3]); return w; }
__device__ __forceinline__ void unpack8f(u32x4 w, f32x4& a, f32x4& b) { a = (f32x4){bflo(w.x), bfhi(w.x), bflo(w.y), bfhi(w.y)}; b = (f32x4){bflo(w.z), bfhi(w.z), bflo(w.w), bfhi(w.w)}; }
__device__ __forceinline__ f32x4 sig4(f32x4 v) { return (f32x4){sigmoidf_(v[0]), sigmoidf_(v[1]), sigmoidf_(v[2]), sigmoidf_(v[3])}; }

struct EpiP1 {
    static constexpr bool PERM = true;
    bf16_t *cq, *kva, *qkvb, *gates; float* misc; const float* gqb; const float* gkb; LAS float* xch;
    __device__ __forceinline__ void operator()(const f32x4 (&acc)[2][2][4][2], const Unit& u, int wr, int wc, int fr, int fq) const {
        const int pn = u.pn, cl = wc * 32 + 8 * fq;
        if (pn >= 7 && pn < 23) {
            const int t = (pn - 7) >> 3;
            const float* gp = (t ? gkb : gqb) + cl;
            const f32x4 g0 = *(const f32x4*)gp, g1 = *(const f32x4*)(gp + 4);
#pragma unroll
            for (int ai = 0; ai < 2; ++ai)
#pragma unroll
                for (int m = 0; m < 4; ++m)
#pragma unroll
                    for (int bj = 0; bj < 2; ++bj) { const f32x4 a0 = acc[ai][bj][m][0], a1 = acc[ai][bj][m][1];
                        float v = (a0[0] * a0[0] + a0[1] * a0[1]) + (a0[2] * a0[2] + a0[3] * a0[3]) + (a1[0] * a1[0] + a1[1] * a1[1]) + (a1[2] * a1[2] + a1[3] * a1[3]);
                        v += __shfl_xor(v, 16); v += __shfl_xor(v, 32);
                        if (fq == 0) xch[((((wr * 2 + ai) * 4 + m) * 16 + fr) * 2 + bj) * 4 + wc] = v; }
            LDS_WAIT(); __builtin_amdgcn_s_barrier();
            bf16_t* base = qkvb + (size_t)t * ((size_t)M * 2048) + ((pn - 7) & 7) * 256 + cl;
            EPI_ROWS_BEGIN
                bf16_t* rowp = base + row * 2048;
#pragma unroll
                for (int bj = 0; bj < 2; ++bj) { const f32x4 p4 = *(const LAS f32x4*)(xch + ((((wr * 2 + ai) * 4 + m) * 16 + fr) * 2 + bj) * 4);
                    const float rstd = 1.0f / sqrtf(((p4[0] + p4[1]) + (p4[2] + p4[3])) * (1.f / 128.f) + EPS);
                    *(u32x4*)(rowp + bj * HALF) = pack8f(acc[ai][bj][m][0] * rstd * g0, acc[ai][bj][m][1] * rstd * g1); }
            EPI_ROWS_END
            return;
        }
        if (pn == 6) {
            EPI_ROWS_BEGIN
                float* rowp = misc + row * 256 + cl;
#pragma unroll
                for (int bj = 0; bj < 2; ++bj) { *(f32x4*)(rowp + bj * HALF) = acc[ai][bj][m][0]; *(f32x4*)(rowp + bj * HALF + 4) = acc[ai][bj][m][1]; }
            EPI_ROWS_END
            return;
        }
        bf16_t* base; int ldc;
        if (pn >= 31) { base = gates + (pn - 31) * 256; ldc = 8192; }
        else if (pn < 4) { base = cq + pn * 256; ldc = 1024; }
        else if (pn < 6) { base = kva + (pn - 4) * 256; ldc = 512; }
        else { const int t = (pn - 7) >> 3; base = qkvb + (size_t)t * ((size_t)M * 2048) + ((pn - 7) & 7) * 256; ldc = 2048; }
        base += cl;
        EPI_ROWS_BEGIN
            bf16_t* rowp = base + row * ldc;
#pragma unroll
            for (int bj = 0; bj < 2; ++bj) *(u32x4*)(rowp + bj * HALF) = pack8f(acc[ai][bj][m][0], acc[ai][bj][m][1]);
        EPI_ROWS_END
    }
};
struct EpiBf16 {
    static constexpr bool PERM = true;
    bf16_t* O; int ldc; int split_cols; size_t split_stride;
    __device__ __forceinline__ void operator()(const f32x4 (&acc)[2][2][4][2], const Unit& u, int wr, int wc, int fr, int fq) const {
        int colt = u.pn * BM; bf16_t* base = O;
        if (split_cols) { const int t = colt / split_cols; base += (size_t)t * split_stride; colt -= t * split_cols; }
        base += colt + wc * 32 + 8 * fq;
        EPI_ROWS_BEGIN
            bf16_t* rowp = base + row * ldc;
#pragma unroll
            for (int bj = 0; bj < 2; ++bj) *(u32x4*)(rowp + bj * HALF) = pack8f(acc[ai][bj][m][0], acc[ai][bj][m][1]);
        EPI_ROWS_END
    }
};
struct EpiMerge {
    static constexpr bool PERM = true;
    const bf16_t* gates; bf16_t* pscr; bf16_t* merged;
    __device__ __forceinline__ void operator()(const f32x4 (&acc)[2][2][4][2], const Unit& u, int wr, int wc, int fr, int fq) const {
        const int col = u.pn * BM + wc * 32 + 8 * fq;
#pragma unroll
        for (int ai = 0; ai < 2; ++ai) {
            const size_t row0 = (size_t)(u.pm * BM + ai * HALF + wr * 64 + fr);
            u32x4 gq[4][2], pq[4][2];
#pragma unroll
            for (int m = 0; m < 4; ++m)
#pragma unroll
                for (int bj = 0; bj < 2; ++bj) { const size_t row = row0 + m * 16;
                    gq[m][bj] = *(const u32x4*)(gates + row * 8192 + (size_t)u.z * 4096 + col + bj * HALF);
                    if (u.z != 0) pq[m][bj] = *(const u32x4*)(pscr + row * 4096 + col + bj * HALF); else pq[m][bj] = (u32x4){0u, 0u, 0u, 0u}; }
            asm volatile("" ::: "memory");
#pragma unroll
            for (int m = 0; m < 4; ++m)
#pragma unroll
                for (int bj = 0; bj < 2; ++bj) { const size_t o = (row0 + m * 16) * 4096 + col + bj * HALF;
                    f32x4 g0, g1; unpack8f(gq[m][bj], g0, g1);
                    f32x4 v0 = acc[ai][bj][m][0] * sig4(g0), v1 = acc[ai][bj][m][1] * sig4(g1);
                    if (u.z == 0) *(u32x4*)(pscr + o) = pack8f(v0, v1);
                    else { f32x4 p0, p1; unpack8f(pq[m][bj], p0, p1); *(u32x4*)(merged + o) = pack8f(v0 + p0, v1 + p1); } }
            asm volatile("" ::: "memory");
        }
    }
};
struct EpiResid {
    static constexpr bool PERM = true;
    const float* base; float* out;
    __device__ __forceinline__ void operator()(const f32x4 (&acc)[2][2][4][2], const Unit& u, int wr, int wc, int fr, int fq) const {
        const int col = u.pn * BM + wc * 32 + 8 * fq;
        EPI_ROWS_BEGIN
#pragma unroll
            for (int bj = 0; bj < 2; ++bj) { const size_t o = row * 4096 + col + bj * HALF;
                const f32x4 b0 = *(const f32x4*)(base + o), b1 = *(const f32x4*)(base + o + 4);
                *(f32x4*)(out + o) = b0 + acc[ai][bj][m][0]; *(f32x4*)(out + o + 4) = b1 + acc[ai][bj][m][1]; }
            if (m & 1) asm volatile("" ::: "memory");
        EPI_ROWS_END
    }
};
template <bool BASE_BF16>
struct EpiResidNorm {
    static constexpr bool PERM = true;
    const void* base; bf16_t* xb; float* ss;
    __device__ __forceinline__ void operator()(const f32x4 (&acc)[2][2][4][2], const Unit& u, int wr, int wc, int fr, int fq) const {
        const int col = u.pn * BM + wc * 32 + 8 * fq;
#pragma unroll
        for (int ai = 0; ai < 2; ++ai) {
            const size_t row0 = (size_t)(u.pm * BM + ai * HALF + wr * 64 + fr);
            f32x4 bq[4][2][2];
            if (BASE_BF16) {
                u32x4 raw[4][2];
#pragma unroll
                for (int m = 0; m < 4; ++m)
#pragma unroll
                    for (int bj = 0; bj < 2; ++bj) raw[m][bj] = *(const u32x4*)((const bf16_t*)base + (row0 + m * 16) * 4096 + col + bj * HALF);
                asm volatile("" ::: "memory");
#pragma unroll
                for (int m = 0; m < 4; ++m)
#pragma unroll
                    for (int bj = 0; bj < 2; ++bj) unpack8f(raw[m][bj], bq[m][bj][0], bq[m][bj][1]);
            } else {
#pragma unroll
                for (int m = 0; m < 4; ++m)
#pragma unroll
                    for (int bj = 0; bj < 2; ++bj) { const float* p = (const float*)base + (row0 + m * 16) * 4096 + col + bj * HALF; bq[m][bj][0] = *(const f32x4*)p; bq[m][bj][1] = *(const f32x4*)(p + 4); }
                asm volatile("" ::: "memory");
            }
#pragma unroll
            for (int m = 0; m < 4; ++m) { const size_t row = row0 + m * 16;
                float sq = 0.f;
#pragma unroll
                for (int bj = 0; bj < 2; ++bj) { const size_t o = row * 4096 + col + bj * HALF;
                    const f32x4 v0 = bq[m][bj][0] + acc[ai][bj][m][0], v1 = bq[m][bj][1] + acc[ai][bj][m][1];
                    *(u32x4*)(xb + o) = pack8f(v0, v1);
                    sq += (v0[0] * v0[0] + v0[1] * v0[1]) + (v0[2] * v0[2] + v0[3] * v0[3]) + (v1[0] * v1[0] + v1[1] * v1[1]) + (v1[2] * v1[2] + v1[3] * v1[3]); }
                sq += __shfl_xor(sq, 16); sq += __shfl_xor(sq, 32);
                if (fq == 0) atomicAdd(ss + row, sq); }
            asm volatile("" ::: "memory");
        }
    }
};
struct EpiSwiGLU {
    static constexpr bool PERM = true;
    bf16_t* act; const float* ss;
    __device__ __forceinline__ void operator()(const f32x4 (&acc)[2][2][4][2], const Unit& u, int wr, int wc, int fr, int fq) const {
        bf16_t* base = act + u.pn * HALF + wc * 32 + 8 * fq;
        float sq[2][4];
#pragma unroll
        for (int ai = 0; ai < 2; ++ai)
#pragma unroll
            for (int m = 0; m < 4; ++m) sq[ai][m] = ss[u.pm * BM + ai * HALF + wr * 64 + m * 16 + fr];
        asm volatile("" ::: "memory");
        EPI_ROWS_BEGIN
            const float r = 1.0f / sqrtf(sq[ai][m] * (1.f / 4096.f) + EPS);
            const f32x4 g0 = acc[ai][0][m][0] * r, g1 = acc[ai][0][m][1] * r;
            *(u32x4*)(base + row * DFF) = pack8f(g0 * sig4(g0) * (acc[ai][1][m][0] * r), g1 * sig4(g1) * (acc[ai][1][m][1] * r));
        EPI_ROWS_END
    }
};
struct EpiPle {
    static constexpr bool PERM = true;
    const bf16_t* E; const bf16_t* x2; float* out; const float* ss;
    __device__ __forceinline__ void operator()(const f32x4 (&acc)[2][2][4][2], const Unit& u, int wr, int wc, int fr, int fq) const {
        const int col = u.pn * BM + wc * 32 + 8 * fq;
#pragma unroll
        for (int ai = 0; ai < 2; ++ai) {
            const size_t row0 = (size_t)(u.pm * BM + ai * HALF + wr * 64 + fr);
            u32x4 eq[4][2], xq[4][2]; float sq[4];
#pragma unroll
            for (int m = 0; m < 4; ++m) { sq[m] = ss[row0 + m * 16];
#pragma unroll
                for (int bj = 0; bj < 2; ++bj) { const size_t o = (row0 + m * 16) * 4096 + col + bj * HALF;
                    eq[m][bj] = *(const u32x4*)(E + o); xq[m][bj] = *(const u32x4*)(x2 + o); } }
            asm volatile("" ::: "memory");
#pragma unroll
            for (int m = 0; m < 4; ++m) {
                const float r = 1.0f / sqrtf(sq[m] * (1.f / 4096.f) + EPS);
#pragma unroll
                for (int bj = 0; bj < 2; ++bj) { const size_t o = (row0 + m * 16) * 4096 + col + bj * HALF;
                    f32x4 e0, e1, b0, b1; unpack8f(eq[m][bj], e0, e1); unpack8f(xq[m][bj], b0, b1);
                    *(f32x4*)(out + o) = b0 + sig4(acc[ai][bj][m][0] * r) * e0; *(f32x4*)(out + o + 4) = b1 + sig4(acc[ai][bj][m][1] * r) * e1; } }
            asm volatile("" ::: "memory");
        }
    }
};
#undef EPI_ROWS_BEGIN
#undef EPI_ROWS_END
}

namespace fa {
constexpr int NW = 8, QBLK = 32, KVBLK = 64, QB = NW * QBLK, D = 128;
constexpr int SHM_V = KVBLK * D * 2, SHM_K = KVBLK * D * 2;
constexpr int LDS_USE = 2 * SHM_V + 2 * SHM_K + NW * 64 * 4;
constexpr float THR = 8.f;
#define KSWZ(row, colB) ((row) * 256 + ((colB) ^ (((row) & 7) << 4)))
#ifdef FA_HEAVY
#define SBAR() do { asm volatile("s_waitcnt vmcnt(0) lgkmcnt(0)" ::: "memory"); __syncthreads(); } while (0)
#else
#define SBAR() __builtin_amdgcn_sched_barrier(0)
#endif
__device__ __forceinline__ int v_st(int k, int c) { const int kk = (k & ~0xC) | ((k & 4) << 1) | ((k & 8) >> 1); return ((kk >> 3) * 4 + (c >> 5)) * 512 + ((kk & 7) * 32 + (c & 31)) * 2; }
__device__ __forceinline__ int v_rd_base(int lane) { return ((lane & 3) << 3) | (((lane >> 2) & 3) << 6) | (((lane >> 4) & 1) << 5) | (((lane >> 5) & 1) << 8); }
constexpr int v_rd_off(int d0, int ks, int half) { return d0 * 512 + ks * 4096 + half * 2048; }
__device__ __forceinline__ int crow(int r, int hi) { return (r & 3) + 8 * (r >> 2) + 4 * hi; }

__device__ __forceinline__ void mask_causal(f32x16& p0, f32x16& p1, int dq) {
    const float NEG = -__builtin_inff();
#pragma unroll
    for (int r = 0; r < 16; ++r) {
        const int c = (r & 3) + 8 * (r >> 2);
        if (dq - c < 0) p0[r] = NEG;
        if (dq - c - 32 < 0) p1[r] = NEG;
    }
}
__device__ __forceinline__ void mask_bits(f32x16& p0, f32x16& p1, unsigned long long mk, int hi) {
    const float NEG = -__builtin_inff();
    const unsigned lo = (unsigned)mk >> (4 * hi), hh = (unsigned)(mk >> 32) >> (4 * hi);
#pragma unroll
    for (int r = 0; r < 16; ++r) {
        const int c = (r & 3) + 8 * (r >> 2);
        if (!(lo & (1u << c))) p0[r] = NEG;
        if (!(hh & (1u << c))) p1[r] = NEG;
    }
}
__device__ __forceinline__ void partialSM(f32x16& p0, f32x16& p1, float& m_reg, float& mn, float& alpha) {
    float pmax = p0[0];
#pragma unroll
    for (int r = 1; r < 16; ++r) pmax = fmaxf(pmax, p0[r]);
#pragma unroll
    for (int r = 0; r < 16; ++r) pmax = fmaxf(pmax, p1[r]);
    { auto rr = __builtin_amdgcn_permlane32_swap(__float_as_uint(pmax), __float_as_uint(pmax), false, false);
      pmax = fmaxf(__uint_as_float(rr[0]), __uint_as_float(rr[1])); }
    constexpr float C2 = 1.4426950408889634f * SM_SCALE;
    if (__builtin_expect(__all((pmax - m_reg) * SM_SCALE <= THR), 1)) { mn = m_reg; alpha = 1.f; }
    else { mn = fmaxf(m_reg, pmax); alpha = __builtin_amdgcn_exp2f((m_reg - mn) * C2); m_reg = mn; }
    const float mnL = -mn * C2;
#pragma unroll
    for (int r = 0; r < 16; ++r) p0[r] = fmaf(p0[r], C2, mnL);
#pragma unroll
    for (int r = 0; r < 16; ++r) p1[r] = fmaf(p1[r], C2, mnL);
#pragma unroll
    for (int r = 0; r < 16; ++r) p0[r] = __builtin_amdgcn_exp2f(p0[r]);
}
__device__ __forceinline__ void finishSM(f32x16& p0, f32x16& p1, float alpha, float& l_reg, bf16x8& pa0, bf16x8& pa1, bf16x8& pa2, bf16x8& pa3) {
#pragma unroll
    for (int r = 0; r < 16; ++r) p1[r] = __builtin_amdgcn_exp2f(p1[r]);
    float ps = 0;
#pragma unroll
    for (int r = 0; r < 16; ++r) ps += p0[r];
#pragma unroll
    for (int r = 0; r < 16; ++r) ps += p1[r];
    { auto rr = __builtin_amdgcn_permlane32_swap(__float_as_uint(ps), __float_as_uint(ps), false, false);
      ps = __uint_as_float(rr[0]) + __uint_as_float(rr[1]); }
    l_reg = l_reg * alpha + ps;
#define PK4(P, B_, OUT) do { unsigned a0 = cvtpk(P[B_+0], P[B_+1]), a1 = cvtpk(P[B_+2], P[B_+3]);                          \
        unsigned b0 = cvtpk(P[B_+4], P[B_+5]), b1 = cvtpk(P[B_+6], P[B_+7]);                                             \
        auto r0 = __builtin_amdgcn_permlane32_swap(a0, b0, false, false); auto r1 = __builtin_amdgcn_permlane32_swap(a1, b1, false, false); \
        u32x4 w = {r0[0], r1[0], r0[1], r1[1]}; OUT = *reinterpret_cast<bf16x8*>(&w); } while (0)
    PK4(p0, 0, pa0); PK4(p0, 8, pa1); PK4(p1, 0, pa2); PK4(p1, 8, pa3);
#undef PK4
}
__device__ __forceinline__ bf16x8 bias_frag(float x, int hi) {
    const unsigned b1 = f2bf(x); const float r1 = x - __uint_as_float(b1 << 16);
    const unsigned b2 = f2bf(r1); const float r2 = r1 - __uint_as_float(b2 << 16);
    const unsigned b3 = f2bf(r2);
    u32x4 w = {hi ? 0u : (b1 | (b2 << 16)), hi ? 0u : b3, 0u, 0u};
    return *reinterpret_cast<bf16x8*>(&w);
}
template <int KB, int MODE>
__device__ __forceinline__ void qkt(f32x16& p0, f32x16& p1, const char* K_lds, int r32, int hi, const bf16x8* qr, float bz0, float bz1) {
    p0 = f32x16{}; p1 = f32x16{};
    if (MODE == 0) {
        unsigned hm = (unsigned)hi - 1u; asm volatile("" : "+v"(hm));
        u32x4 ow = {hm & 0x3f803f80u, hm & 0x00003f80u, 0u, 0u};
        const bf16x8 ones = *reinterpret_cast<bf16x8*>(&ow);
        p0 = __builtin_amdgcn_mfma_f32_32x32x16_bf16(bias_frag(bz0, hi), ones, p0, 0, 0, 0);
        p1 = __builtin_amdgcn_mfma_f32_32x32x16_bf16(bias_frag(bz1, hi), ones, p1, 0, 0, 0);
    }
    const char* kb[4];
#pragma unroll
    for (int dd = 0; dd < 4; ++dd) kb[dd] = K_lds + KB * SHM_K + KSWZ(r32, (dd * 16 + hi * 8) * 2);
#pragma unroll
    for (int d0 = 0; d0 < 8; ++d0) { const char* a = kb[d0 & 3] + (d0 >> 2) * 128;
        bf16x8 b0 = *reinterpret_cast<const bf16x8*>(a);
        bf16x8 b1 = *reinterpret_cast<const bf16x8*>(a + 32 * 256);
        p0 = __builtin_amdgcn_mfma_f32_32x32x16_bf16(b0, qr[d0], p0, 0, 0, 0);
        p1 = __builtin_amdgcn_mfma_f32_32x32x16_bf16(b1, qr[d0], p1, 0, 0, 0); }
}
template <int VB>
__device__ __forceinline__ void pv_tile(f32x16* o, int vb0, bf16x8 pa0, bf16x8 pa1, bf16x8 pa2, bf16x8 pa3) {
#define TRRD(dst, off) asm volatile("ds_read_b64_tr_b16 %0, %1 offset:%2" : "=&v"(dst) : "v"(vb0), "i"(off) : "memory")
#define PV_D0(d0) do { s16x4 l0, l1, l2, l3, h0, h1, h2, h3; constexpr int b_ = VB * SHM_V + v_rd_off(d0, 0, 0); \
        TRRD(l0, b_); TRRD(h0, b_ + 2048); TRRD(l1, b_ + 4096); TRRD(h1, b_ + 6144); TRRD(l2, b_ + 8192); TRRD(h2, b_ + 10240); TRRD(l3, b_ + 12288); TRRD(h3, b_ + 14336); \
        asm volatile("s_waitcnt lgkmcnt(0)" ::: "memory"); SBAR();   \
        o[d0] = __builtin_amdgcn_mfma_f32_32x32x16_bf16(pa0, (bf16x8){l0[0], l0[1], l0[2], l0[3], h0[0], h0[1], h0[2], h0[3]}, o[d0], 0, 0, 0);   \
        o[d0] = __builtin_amdgcn_mfma_f32_32x32x16_bf16(pa1, (bf16x8){l1[0], l1[1], l1[2], l1[3], h1[0], h1[1], h1[2], h1[3]}, o[d0], 0, 0, 0);   \
        o[d0] = __builtin_amdgcn_mfma_f32_32x32x16_bf16(pa2, (bf16x8){l2[0], l2[1], l2[2], l2[3], h2[0], h2[1], h2[2], h2[3]}, o[d0], 0, 0, 0);   \
        o[d0] = __builtin_amdgcn_mfma_f32_32x32x16_bf16(pa3, (bf16x8){l3[0], l3[1], l3[2], l3[3], h3[0], h3[1], h3[2], h3[3]}, o[d0], 0, 0, 0); } while (0)
    PV_D0(0); PV_D0(1); PV_D0(2); PV_D0(3);
#undef PV_D0
#undef TRRD
}
struct Ref { const bf16_t* Q; const bf16_t* K; const bf16_t* V; bf16_t* O; const float* bias; const unsigned long long* msk; int P0; int NT; };
struct Seam { bf16x8 qr[8]; bf16x8 st_v0, st_v1, st_k0, st_k1; };
template <int MODE> __device__ __forceinline__ size_t qrow_off(int R) { return MODE == 0 ? (size_t)R * 2048 : (size_t)(R >> 3) * 2048 + (size_t)(R & 7) * 128; }
#define ROW(p, k0, rr) ((p) + (size_t)((k0) + (rr)) * PKV + sc)
#define VMW() asm volatile("s_waitcnt vmcnt(0)" ::: "memory")
#define VMWN(n) asm volatile("s_waitcnt vmcnt(%0)" :: "i"(n) : "memory")
#define LD8(p) (*reinterpret_cast<const bf16x8*>(p))
#define SLOAD_H(Kp, Vp, k0) do { S.st_v0 = LD8(ROW(Vp, k0, sr)); S.st_v1 = LD8(ROW(Vp, k0, 32 + sr));              \
                         S.st_k0 = LD8(ROW(Kp, k0, sr)); S.st_k1 = LD8(ROW(Kp, k0, 32 + sr)); } while (0)
#define SWRITE_HK(bf) do { *(bf16x8*)(K_lds + (bf) * SHM_K + kws) = S.st_k0; *(bf16x8*)(K_lds + (bf) * SHM_K + kws + 32 * 256) = S.st_k1; } while (0)
#define SWRITE_HV(bf) do { *(bf16x8*)(V_lds + (bf) * SHM_V + vst0) = S.st_v0; *(bf16x8*)(V_lds + (bf) * SHM_V + vst1) = S.st_v1; } while (0)
#define SWRITE_H(bf) do { SWRITE_HV(bf); SWRITE_HK(bf); } while (0)
template <int MODE>
__device__ __forceinline__ void prime(const Ref& cur, char* lds, Seam& S) {
    constexpr int PKV = MODE == 0 ? 2048 : 512;
    const int tid = threadIdx.x, wid = __builtin_amdgcn_readfirstlane(tid >> 6), lane = tid & 63, r32 = lane & 31, hi = lane >> 5;
    const int sr = tid >> 4, sc = (tid & 15) * 8, kws = KSWZ(sr, sc * 2); char* K_lds = lds + 2 * SHM_V;
    const bf16_t* qp = cur.Q + qrow_off<MODE>(wid * QBLK + r32) + hi * 8;
#pragma unroll
    for (int d0 = 0; d0 < 8; ++d0) S.qr[d0] = LD8(qp + d0 * 16);
    SLOAD_H(cur.K, cur.V, 0); VMW(); SWRITE_HK(0);
    __syncthreads();
}
template <int MODE>
__device__ __forceinline__ void block(const Ref& cur, const Ref& nxt, char* lds, Seam& S) {
    constexpr int PKV = MODE == 0 ? 2048 : 512;
    const int tid = threadIdx.x, wid = __builtin_amdgcn_readfirstlane(tid >> 6), lane = tid & 63, r32 = lane & 31, hi = lane >> 5;
    const int NT = cur.NT;
    const int qlo = cur.P0 + wid * QBLK, qm = qlo + r32 - 4 * hi;
    char* V_lds = lds; char* K_lds = lds + 2 * SHM_V;
    float* ws = (float*)(lds + 2 * SHM_V + 2 * SHM_K) + wid * 64; float* li_l = ws, * al_l = ws + 32;
    float m_reg = -1e30f, l_reg = 0; f32x16 o[4] = {};
    const int sr = tid >> 4, sc = (tid & 15) * 8, vst0 = v_st(sr, sc), vst1 = v_st(32 + sr, sc), kws = KSWZ(sr, sc * 2);
    const int vb0 = (int)(uintptr_t)V_lds + v_rd_base(lane);
    const bf16_t* Kh = cur.K; const bf16_t* Vh = cur.V;
    const unsigned moff = (unsigned)((wid * 4 + (r32 >> 3)) * 64 * 8);
    unsigned long long mk = 0;
#define RESC(a) do { if (__any((a) < 1.f)) { if (hi == 0) al_l[r32] = (a); asm volatile("s_waitcnt lgkmcnt(0)" ::: "memory");              \
                     for (int d_ = 0; d_ < 4; ++d_) for (int r = 0; r < 16; ++r) o[d_][r] *= al_l[crow(r, hi)]; } } while (0)
#define KBASE(t) ((t) * KVBLK)
#define MASKT(P0_, P1_, t) do { if (MODE == 0) { const int kb_ = KBASE(t); if (kb_ + KVBLK - 1 > qlo) mask_causal(P0_, P1_, qm - kb_); } else mask_bits(P0_, P1_, mk, hi); } while (0)
#define MLOAD_(t, off) do { if (MODE == 1) mk = *(const unsigned long long*)((const char*)(cur.msk + (t)) + (off)); } while (0)
#define MLOAD(t) MLOAD_(t, moff)
#define BLOAD(X0, X1, t) do { if (MODE == 0 && !(MK_DBG & 2)) { X0 = cur.bias[KBASE(t) + r32]; X1 = cur.bias[KBASE(t) + 32 + r32]; } } while (0)
#define SEAM_K0() do { if (QPRE) VMWN(8); else VMWN(0); SWRITE_HK(0); SBAR(); } while (0)
    f32x16 pA0, pA1, pB0, pB1; float mnA, mnB, alA, alB; bf16x8 pa0, pa1, pa2, pa3;
    float bz0 = 0.f, bz1 = 0.f;
    BLOAD(bz0, bz1, 0);
    SWRITE_HV(0); SBAR();
    if (NT > 1) SLOAD_H(Kh, Vh, KBASE(1));
    MLOAD(0);
    SBAR(); qkt<0, MODE>(pA0, pA1, K_lds, r32, hi, S.qr, bz0, bz1);
    if (NT > 1) BLOAD(bz0, bz1, 1);
    MASKT(pA0, pA1, 0); partialSM(pA0, pA1, m_reg, mnA, alA);
    if (NT > 1) { VMW(); SWRITE_H(1); }
    __syncthreads();
#define HALF_STEP(PX0, PX1, mnX, alX, PY0, PY1, alY, t, KB, VB, SB) do {                                                      \
        MLOAD(t); SBAR(); qkt<KB, MODE>(PX0, PX1, K_lds, r32, hi, S.qr, bz0, bz1);                                            \
        finishSM(PY0, PY1, alY, l_reg, pa0, pa1, pa2, pa3); SBAR();                                                           \
        if ((t) + 1 < NT) { SLOAD_H(Kh, Vh, KBASE((t) + 1)); BLOAD(bz0, bz1, (t) + 1); SBAR(); }                              \
        pv_tile<VB>(o, vb0, pa0, pa1, pa2, pa3); MASKT(PX0, PX1, (t)); partialSM(PX0, PX1, m_reg, mnX, alX);                  \
        __syncthreads();                                                                                                      \
        if ((t) + 1 < NT) { VMW(); SWRITE_H(SB); }                                                                            \
        RESC(alX); __syncthreads(); } while (0)
    for (int t = 1; t + 1 < NT; t += 2) {
        HALF_STEP(pB0, pB1, mnB, alB, pA0, pA1, alA, t, 1, 0, 0);
        HALF_STEP(pA0, pA1, mnA, alA, pB0, pB1, alB, t + 1, 0, 1, 1);
    }
    const bool even = (NT & 1) == 0;
    constexpr bool QPRE = (MODE == 1);
    int tid2 = tid; asm volatile("" : "+v"(tid2));
    const int lane2 = tid2 & 63, r32e = lane2 & 31, hie = lane2 >> 5, sre = tid2 >> 4, sce = (tid2 & 15) * 8;
    const unsigned moffe = (unsigned)((wid * 4 + (r32e >> 3)) * 64 * 8);
    if (even) { MLOAD_(NT - 1, moffe); SBAR(); qkt<1, MODE>(pB0, pB1, K_lds, r32, hi, S.qr, bz0, bz1); SBAR(); }
    { const bf16_t* vp = nxt.V + (size_t)sre * PKV + sce; const bf16_t* kp = nxt.K + (size_t)sre * PKV + sce;
      S.st_v0 = LD8(vp); S.st_v1 = LD8(vp + (size_t)32 * PKV); S.st_k0 = LD8(kp); S.st_k1 = LD8(kp + (size_t)32 * PKV); SBAR();
      if (QPRE) { const bf16_t* qp = nxt.Q + qrow_off<MODE>(wid * QBLK + r32e) + hie * 8;
#pragma unroll
      for (int d0 = 0; d0 < 8; ++d0) S.qr[d0] = LD8(qp + d0 * 16); } }
    SBAR();
    finishSM(pA0, pA1, alA, l_reg, pa0, pa1, pa2, pa3); SBAR();
    pv_tile<0>(o, vb0, pa0, pa1, pa2, pa3);
    if (even) { MASKT(pB0, pB1, NT - 1); partialSM(pB0, pB1, m_reg, mnB, alB); __syncthreads(); RESC(alB);
        finishSM(pB0, pB1, alB, l_reg, pa0, pa1, pa2, pa3); SBAR(); pv_tile<1>(o, vb0, pa0, pa1, pa2, pa3); }
    SBAR(); SEAM_K0();
    if (hie == 0) li_l[r32e] = l_reg; asm volatile("s_waitcnt lgkmcnt(0)" ::: "memory");
    float rli[16];
#pragma unroll
    for (int r = 0; r < 16; ++r) rli[r] = __builtin_amdgcn_rcpf(li_l[crow(r, hie)]);
#pragma unroll
    for (int r = 0; r < 16; ++r) { bf16_t* orow = cur.O + qrow_off<MODE>(wid * QBLK + crow(r, hie));
#pragma unroll
        for (int d0 = 0; d0 < 4; ++d0) { const float v = o[d0][r] * rli[r];
            const float vn = __shfl_xor(v, 1);
            if ((r32e & 1) == 0) *(unsigned*)(orow + d0 * 32 + r32e) = cvtpk(v, vn); } }
    if (!QPRE) { SBAR(); const bf16_t* qp = nxt.Q + qrow_off<MODE>(wid * QBLK + r32e) + hie * 8;
#pragma unroll
        for (int d0 = 0; d0 < 8; ++d0) S.qr[d0] = LD8(qp + d0 * 16); }
    __syncthreads();
#undef RESC
#undef KBASE
#undef MASKT
#undef MLOAD
#undef MLOAD_
#undef BLOAD
#undef SEAM_K0
#undef HALF_STEP
}
template <int MODE>
__device__ __forceinline__ void sblock(const Ref& cur, char* lds) {
    constexpr int PKV = MODE == 0 ? 2048 : 512;
    const int tid = threadIdx.x, wid = __builtin_amdgcn_readfirstlane(tid >> 6), lane = tid & 63, r32 = lane & 31, hi = lane >> 5;
    const int NT = cur.NT;
    const int qlo = cur.P0 + wid * QBLK, qm = qlo + r32 - 4 * hi;
    char* V_lds = lds; char* K_lds = lds + 2 * SHM_V;
    float* ws = (float*)(lds + 2 * SHM_V + 2 * SHM_K) + wid * 64; float* li_l = ws, * al_l = ws + 32;
    float m_reg = -1e30f, l_reg = 0; f32x16 o[4] = {};
    const int sr = tid >> 4, sc = (tid & 15) * 8, vst0 = v_st(sr, sc), vst1 = v_st(32 + sr, sc), kws = KSWZ(sr, sc * 2);
    const int vb0 = (int)(uintptr_t)V_lds + v_rd_base(lane);
    const unsigned moff = (unsigned)((wid * 4 + (r32 >> 3)) * 64 * 8);
    bf16x8 qr[8];
    { const bf16_t* qp = cur.Q + qrow_off<MODE>(wid * QBLK + r32) + hi * 8;
#pragma unroll
      for (int d0 = 0; d0 < 8; ++d0) qr[d0] = LD8(qp + d0 * 16); }
    Seam S;
    SLOAD_H(cur.K, cur.V, 0);
    for (int t = 0; t < NT; ++t) {
        float bz0 = 0.f, bz1 = 0.f; unsigned long long mk = 0;
        if (MODE == 0 && !(MK_DBG & 2)) { bz0 = cur.bias[t * KVBLK + r32]; bz1 = cur.bias[t * KVBLK + 32 + r32]; }
        if (MODE == 1) mk = *(const unsigned long long*)((const char*)(cur.msk + t) + moff);
        __syncthreads();
        VMW(); SWRITE_H(0);
        if (t + 1 < NT) SLOAD_H(cur.K, cur.V, (t + 1) * KVBLK);
        __syncthreads();
        f32x16 p0, p1; float mn, al; bf16x8 pa0, pa1, pa2, pa3;
        qkt<0, MODE>(p0, p1, K_lds, r32, hi, qr, bz0, bz1);
        if (MODE == 0) { const int kb_ = t * KVBLK; if (kb_ + KVBLK - 1 > qlo) mask_causal(p0, p1, qm - kb_); } else mask_bits(p0, p1, mk, hi);
        partialSM(p0, p1, m_reg, mn, al);
        if (__any(al < 1.f)) { if (hi == 0) al_l[r32] = al; asm volatile("s_waitcnt lgkmcnt(0)" ::: "memory");
            for (int d_ = 0; d_ < 4; ++d_) for (int r = 0; r < 16; ++r) o[d_][r] *= al_l[crow(r, hi)]; }
        finishSM(p0, p1, al, l_reg, pa0, pa1, pa2, pa3);
        pv_tile<0>(o, vb0, pa0, pa1, pa2, pa3);
    }
    if (hi == 0) li_l[r32] = l_reg; asm volatile("s_waitcnt lgkmcnt(0)" ::: "memory");
    float rli[16];
#pragma unroll
    for (int r = 0; r < 16; ++r) rli[r] = __builtin_amdgcn_rcpf(li_l[crow(r, hi)]);
#pragma unroll
    for (int r = 0; r < 16; ++r) { bf16_t* orow = cur.O + qrow_off<MODE>(wid * QBLK + crow(r, hi));
#pragma unroll
        for (int d0 = 0; d0 < 4; ++d0) { const float v = o[d0][r] * rli[r];
            const float vn = __shfl_xor(v, 1);
            if ((r32 & 1) == 0) *(unsigned*)(orow + d0 * 32 + r32) = cvtpk(v, vn); } }
    __syncthreads();
}
#undef ROW
#undef VMW
#undef VMWN
#undef LD8
#undef SLOAD_H
#undef SWRITE_HK
#undef SWRITE_HV
#undef SWRITE_H
}

constexpr int NWAVES = 8;
struct Args { const void* in[25]; float* out; unsigned char* ws; int ph_lo, ph_hi; };
#define GAS __attribute__((address_space(1)))
#define CAS __attribute__((address_space(4)))
struct ArgsD { const GAS void* in[25]; GAS float* out; GAS unsigned char* ws; int ph_lo, ph_hi; };
typedef const CAS ArgsD* ArgsP;
__device__ __forceinline__ ArgsP get_args() { unsigned long long p = (unsigned long long)__builtin_amdgcn_kernarg_segment_ptr(); asm volatile("" : "+s"(p)); return (ArgsP)p; }
struct Frame {
    LAS unsigned char* lds; char* ldsg; volatile LAS unsigned* MISC;
    int tid, lane, wave, vcu, G, gw, NGW;
};
enum { I_X = 0, I_P, I_POS, I_GATTN, I_WIN, I_GCQ, I_WUQ, I_WUQI, I_GKIDX, I_BKIDX, I_GQA, I_GKA, I_BFORGET, I_GQB, I_GKB, I_WUPA, I_WUPB, I_WO, I_GFFN, I_WFG, I_WFU, I_WFD, I_GPLE, I_WPLE, I_WPLEG };

constexpr int TR_STRIP = 64 * 65 * 4;
struct TrItem { const float* W; bf16_t* WT; const float* gain; int ldw, K, n0, k0, scol4; };
__device__ __forceinline__ void tr_load(const TrItem& it, f32x4 (&v)[16], int lane) {
    const float* p = it.W + (size_t)(it.k0 + (lane >> 4)) * it.ldw + (it.scol4 < 0 ? 0 : it.scol4);
#pragma unroll
    for (int q = 0; q < 16; ++q) v[q] = __builtin_nontemporal_load((const f32x4*)(p + (size_t)(4 * q) * it.ldw));
    if (it.gain) {
#pragma unroll
        for (int q = 0; q < 16; ++q) v[q] = v[q] * it.gain[it.k0 + 4 * q + (lane >> 4)]; }
    else if (it.scol4 < 0) {
#pragma unroll
        for (int q = 0; q < 16; ++q) v[q] = (f32x4){0.f, 0.f, 0.f, 0.f}; }
}
__device__ __forceinline__ void tr_store(const TrItem& it, const f32x4 (&v)[16], LAS float* scr, int lane) {
    const int cb = (lane & 15) * 4;
#pragma unroll
    for (int q = 0; q < 16; ++q) { LAS float* r = scr + (4 * q + (lane >> 4)) * 65 + cb; r[0] = v[q].x; r[1] = v[q].y; r[2] = v[q].z; r[3] = v[q].w; }
    LDS_WAIT(); asm volatile("" ::: "memory");
    const int c = lane & 7;
#pragma unroll
    for (int j = 0; j < 8; ++j) { const int n = (lane >> 3) + 8 * j; const LAS float* sp = scr + (8 * c) * 65 + n;
        u32x4 o; o.x = pk2(sp[0 * 65], sp[1 * 65]); o.y = pk2(sp[2 * 65], sp[3 * 65]); o.z = pk2(sp[4 * 65], sp[5 * 65]); o.w = pk2(sp[6 * 65], sp[7 * 65]);
        *(u32x4*)(it.WT + (size_t)(it.n0 + n) * it.K + it.k0 + 8 * c) = o; }
    LDS_WAIT(); asm volatile("" ::: "memory");
}
__device__ __forceinline__ int win_src_col(int n) {
    if (n < 1632) return n;
    if (n < 1648) return 7776 + (n - 1632);
    if (n < 1792) return -1;
    if (n < 7936) return 1632 + (n - 1792);
    return 7792 + (n - 7936);
}
__device__ __forceinline__ void rms_row_to_bf16(const float* xrow, const float* g, bf16_t* orow, int lane) {
    const f32x4* xr = (const f32x4*)xrow + lane;
    f32x4 v[16]; float s = 0.f;
#pragma unroll
    for (int j = 0; j < 16; ++j) { v[j] = __builtin_nontemporal_load(xr + 64 * j); s += (v[j].x * v[j].x + v[j].y * v[j].y) + (v[j].z * v[j].z + v[j].w * v[j].w); }
    const float rstd = 1.0f / sqrtf(wave_sum(s) * (1.f / 4096.f) + EPS);
    const f32x4* gr = (const f32x4*)g + lane;
    unsigned long long* o8 = (unsigned long long*)orow + lane;
#pragma unroll
    for (int j = 0; j < 16; ++j) { const f32x4 gg = gr[64 * j];
        o8[64 * j] = (unsigned long long)pk2(v[j].x * rstd * gg.x, v[j].y * rstd * gg.y) | ((unsigned long long)pk2(v[j].z * rstd * gg.z, v[j].w * rstd * gg.w) << 32); }
}
__device__ __forceinline__ void rms_phase(Frame& F, const float* X, const float* g, bf16_t* O) {
    for (int m = F.gw; m < M; m += F.NGW) rms_row_to_bf16(X + (size_t)m * DM, g, O + (size_t)m * DM, F.lane);
}

constexpr int TJ1 = 252 * 64, TJ3 = 64 * 16, TJPL = 64 * 4, TJUP = 64 * 32, TJO = 64 * 64, TJPG = 64 * 64, TJGU = 344 * 64, TJD = 64 * 172;
constexpr int TR_A = TJ1 + TJ3 + TJPL, TR_B = TR_A + 2 * TJUP + TJO, TR_C = TR_B + TJGU, TR_D = TR_C + TJPG + TJD;
__device__ __forceinline__ void tr_convert(Frame& F, ArgsP a, int lo, int hi, int w0, int nw) {
    LAS float* scr = (LAS float*)(F.lds + F.wave * TR_STRIP);
    auto mk = [&](int it) { TrItem t; t.gain = nullptr; int r = it; const int c4 = (F.lane & 15) * 4;
        if (r < TJ1) { const int kb = r / 252, nb = r % 252; t.W = (const float*)a->in[I_WIN]; t.ldw = INW; t.K = DM; t.WT = (bf16_t*)(a->ws + WS_RB); t.n0 = nb * 64; t.k0 = kb * 64; t.scol4 = win_src_col(nb * 64 + c4); return t; } r -= TJ1;
        if (r < TJ3) { const int kb = r / 64, nb = r % 64; t.W = (const float*)a->in[nb >= 32 ? I_WUQI : I_WUQ]; t.ldw = 2048; t.K = QRANK; t.WT = (bf16_t*)(a->ws + WS_W3T); t.n0 = nb * 64; t.k0 = kb * 64; t.scol4 = (nb & 31) * 64 + c4; return t; } r -= TJ3;
        if (r < TJPL) { const int kb = r / 64, nb = r % 64; t.W = (const float*)a->in[I_WPLE]; t.ldw = DM; t.K = PLE; t.WT = (bf16_t*)(a->ws + WS_WPLET); t.n0 = nb * 64; t.k0 = kb * 64; t.scol4 = nb * 64 + c4; return t; } r -= TJPL;
        if (r < 2 * TJUP) { const bool bb = r >= TJUP; if (bb) r -= TJUP; const int kb = r / 64, nb = r % 64; t.W = (const float*)a->in[bb ? I_WUPB : I_WUPA]; t.ldw = DM; t.K = 2048; t.WT = (bf16_t*)(a->ws + (bb ? WS_WUPB : WS_WUPA)); t.n0 = nb * 64; t.k0 = kb * 64; t.scol4 = nb * 64 + c4; return t; } r -= 2 * TJUP;
        if (r < TJO) { const int kb = r / 64, nb = r % 64; t.W = (const float*)a->in[I_WO]; t.ldw = DM; t.K = DM; t.WT = (bf16_t*)(a->ws + WS_WO); t.n0 = nb * 64; t.k0 = kb * 64; t.scol4 = nb * 64 + c4; return t; } r -= TJO;
        if (r < TJGU) { const int kb = r / 344, nb = r % 344; const int n0 = nb * 64, pn = n0 >> 8, rr = n0 & 255; const bool up = rr >= 128;
            t.W = (const float*)a->in[up ? I_WFU : I_WFG]; t.ldw = DFF; t.K = DM; t.WT = (bf16_t*)(a->ws + WS_WGU); t.gain = (const float*)a->in[I_GFFN]; t.n0 = n0; t.k0 = kb * 64; t.scol4 = pn * 128 + (rr & 127) + c4; return t; } r -= TJGU;
        if (r < TJPG) { const int kb = r / 64, nb = r % 64; t.W = (const float*)a->in[I_WPLEG]; t.ldw = DM; t.K = DM; t.WT = (bf16_t*)(a->ws + WS_WPG); t.gain = (const float*)a->in[I_GPLE]; t.n0 = nb * 64; t.k0 = kb * 64; t.scol4 = nb * 64 + c4; return t; } r -= TJPG;
        { const int kb = r / 64, nb = r % 64; t.W = (const float*)a->in[I_WFD]; t.ldw = DM; t.K = DFF; t.WT = (bf16_t*)(a->ws + WS_WD); t.n0 = nb * 64; t.k0 = kb * 64; t.scol4 = nb * 64 + c4; return t; } };
    f32x4 v[16]; int it = lo + w0;
    if (it < hi) { TrItem cur = mk(it); tr_load(cur, v, F.lane);
        for (;;) { const int nx = it + nw; f32x4 w[16];
#pragma unroll
            for (int q = 0; q < 16; ++q) w[q] = v[q];
            TrItem nxt = cur; const bool more = nx < hi; if (more) { nxt = mk(nx); tr_load(nxt, v, F.lane); }
            tr_store(cur, w, scr, F.lane);
            if (!more) break; cur = nxt; it = nx; } }
}

__device__ __forceinline__ void p0_prologue(Frame& F, ArgsP a) {
    tr_convert(F, a, 0, TR_A, F.gw, F.NGW);
    rms_phase(F, (const float*)a->in[I_X], (const float*)a->in[I_GATTN], (bf16_t*)(a->ws + WS_RA));
    { const f32x4* p4 = (const f32x4*)a->in[I_P]; u32x2* o = (u32x2*)(a->ws + WS_PBF);
      for (int i = (blockIdx.x * NWAVES * 64 + F.tid); i < M * PLE / 4; i += F.G * NWAVES * 64) { const f32x4 v = p4[i]; u32x2 w; w.x = pk2(v.x, v.y); w.y = pk2(v.z, v.w); o[i] = w; } }
    { const int* pos = (const int*)a->in[I_POS]; float* ca = (float*)(a->ws + WS_ROPEA); float* sa = ca + (size_t)M * 64; float* ci = (float*)(a->ws + WS_ROPEI); float* si = ci + (size_t)M * 16;
      const double L2T = 13.287712379549449;
      for (int i = (blockIdx.x * NWAVES * 64 + F.tid); i < M * 80; i += F.G * NWAVES * 64) {
          const int m = i / 80, e = i % 80; const bool isA = e < 64; const int k = isA ? e : e - 64;
          const double inv = exp2(-(double)k * (isA ? L2T / 64.0 : L2T / 16.0));
          double rev = (double)pos[m] * inv * 0.15915494309189535; rev -= floor(rev);
          const float fr = (float)rev; const float c = __builtin_amdgcn_cosf(fr), s = __builtin_amdgcn_sinf(fr);
          if (isA) { ca[(size_t)m * 64 + k] = c; sa[(size_t)m * 64 + k] = s; } else { ci[(size_t)m * 16 + k] = c; si[(size_t)m * 16 + k] = s; } } }
}

__device__ __forceinline__ void p2_fixups(Frame& F, ArgsP a) {
    const int lane = F.lane;
    bf16_t* CQ = (bf16_t*)(a->ws + WS_RC); bf16_t* QB = (bf16_t*)(a->ws + WS_RD); bf16_t* KB = QB + (size_t)M * 2048; bf16_t* KVA = (bf16_t*)(a->ws + WS_KVA);
    const float* MISC = (const float*)(a->ws + WS_MISC);
    const float* ca = (const float*)(a->ws + WS_ROPEA); const float* sa = ca + (size_t)M * 64; const float* ci = (const float*)(a->ws + WS_ROPEI); const float* si = ci + (size_t)M * 16;
    bf16_t* KIDX = (bf16_t*)(a->ws + WS_KIDX); float* WIDX = (float*)(a->ws + WS_WIDX);
    const float* gcq = (const float*)a->in[I_GCQ]; const float* gqb = (const float*)a->in[I_GQB]; const float* gkb = (const float*)a->in[I_GKB]; const float* gka = (const float*)a->in[I_GKA];
    const float* gki = (const float*)a->in[I_GKIDX]; const float* bki = (const float*)a->in[I_BKIDX];
    const f32x4 gca = ((const f32x4*)gcq)[2 * lane], gcb = ((const f32x4*)gcq)[2 * lane + 1], gcc = ((const f32x4*)gcq)[2 * lane + 128], gcd = ((const f32x4*)gcq)[2 * lane + 129];
    const int dl = (lane & 15) * 8; const bool hi = (lane & 8) != 0;
    const f32x4 gka0 = *(const f32x4*)(gka + dl), gka1 = *(const f32x4*)(gka + dl + 4);
    const float gkl = gki[lane], bkl = bki[lane];
    for (int m = F.gw; m < M; m += F.NGW) {
        u32x4* pc = (u32x4*)(CQ + (size_t)m * 1024) + lane;
        u32x4* pa = (u32x4*)(KVA + (size_t)m * 512) + (lane & 31);
        const u32x4 w0 = pc[0], w1 = pc[64];
        const u32x4 wa = pa[0];
        const f32x4 c0 = *(const f32x4*)(ca + (size_t)m * 64 + (dl & 63)), c1 = *(const f32x4*)(ca + (size_t)m * 64 + (dl & 63) + 4);
        f32x4 s0 = *(const f32x4*)(sa + (size_t)m * 64 + (dl & 63)), s1 = *(const f32x4*)(sa + (size_t)m * 64 + (dl & 63) + 4);
        const float xi = MISC[(size_t)m * 256 + lane], wi = MISC[(size_t)m * 256 + 64 + (lane & 31)];
        const float cI = ci[(size_t)m * 16 + (lane & 15)], sI = si[(size_t)m * 16 + (lane & 15)];
        asm volatile("" ::: "memory");
        { f32x4 x0, x1, x2, x3; pg8::unpack8f(w0, x0, x1); pg8::unpack8f(w1, x2, x3);
          float s = 0.f;
#pragma unroll
          for (int j = 0; j < 4; ++j) s += x0[j] * x0[j] + x1[j] * x1[j] + x2[j] * x2[j] + x3[j] * x3[j];
          const float rstd = 1.0f / sqrtf(wave_sum(s) * (1.f / 1024.f) + EPS);
          pc[0] = pg8::pack8f(x0 * rstd * gca, x1 * rstd * gcb); pc[64] = pg8::pack8f(x2 * rstd * gcc, x3 * rstd * gcd); }
        { f32x4 x0, x1; pg8::unpack8f(wa, x0, x1);
          float ss = 0.f;
#pragma unroll
          for (int j = 0; j < 4; ++j) ss += x0[j] * x0[j] + x1[j] * x1[j];
          ss += __shfl_xor(ss, 1); ss += __shfl_xor(ss, 2); ss += __shfl_xor(ss, 4); ss += __shfl_xor(ss, 8);
          const float rstd = 1.0f / sqrtf(ss * (1.f / 128.f) + EPS);
          x0 = x0 * rstd * gka0; x1 = x1 * rstd * gka1;
          if (!hi) { s0 = -s0; s1 = -s1; }
          f32x4 y0, y1;
#pragma unroll
          for (int j = 0; j < 4; ++j) { y0[j] = __shfl_xor(x0[j], 8); y1[j] = __shfl_xor(x1[j], 8); }
          if (lane < 32) pa[0] = pg8::pack8f(x0 * c0 + y0 * s0, x1 * c1 + y1 * s1); }
        { const float mu = wave_sum(xi) * (1.f / 64.f); const float d = xi - mu;
          const float rstd = 1.0f / sqrtf(wave_sum(d * d) * (1.f / 64.f) + EPS);
          const float y = d * rstd * gkl + bkl; const float yo = __shfl_xor(y, 16);
          float r = y; if (lane < 16) r = y * cI - yo * sI; else if (lane < 32) r = y * cI + yo * sI;
          KIDX[((((size_t)(m >> 5) * 4 + ((lane >> 3) & 3)) * 64 + (lane >> 5) * 32 + (m & 31)) << 3) + (lane & 7)] = (bf16_t)f2bf(r);
          if (lane < 32) WIDX[(size_t)m * 32 + lane] = wi * 0.022097086912079608f; }
    }
    if (MK_DBG & 2048) { float* bk = (float*)(a->ws + WS_BIASK); const float* bfp = (const float*)a->in[I_BFORGET];
        for (int i = F.gw * 64 + lane; i < BATCH * NH * SEQ; i += F.NGW * 64) { const int bh = i >> 12, sI = i & 4095, b = bh >> 4, h = bh & 15;
            bk[i] = -100.f * (MISC[((size_t)b * SEQ + sI) * 256 + 96 + h] + bfp[h]) * INV_SM_SCALE; } }
    __syncthreads();
    if (blockIdx.x < BATCH * NH && !(MK_DBG & 2048) && (MK_P2MASK & 16)) {
        const int bh = blockIdx.x, b = bh / NH, h = bh % NH; const float bf = (MK_P2MASK & 32) ? 2.5f : ((const float*)a->in[I_BFORGET])[h];
        LAS float* lf = (LAS float*)(F.lds);
        for (int sIdx = F.tid; sIdx < SEQ; sIdx += NWAVES * 64) { const float x = MISC[((size_t)b * SEQ + sIdx) * 256 + 96 + h] + bf; lf[sIdx] = (MK_DBG & 128) ? x : fminf(x, 0.f) - log1pf(expf(-fabsf(x))); if (MK_DBG & 1024) ((float*)(a->ws + WS_BIASK))[(size_t)bh * SEQ + sIdx] = -100.f * x * INV_SM_SCALE; }
        __syncthreads();
        if (F.wave == 0) {
            float tot = 0.f;
            for (int j = 0; j < 64; ++j) tot += lf[lane * 64 + j];
            float inc = tot;
#pragma unroll
            for (int o = 1; o < 64; o <<= 1) { const float t = __shfl_up(inc, o); if (lane >= o) inc += t; }
            float run = inc - tot;
            float* bk = (float*)(a->ws + WS_BIASK) + (size_t)bh * SEQ + lane * 64;
            for (int j = 0; j < 64; ++j) { if (MK_DBG & 256) run = 100.f * lf[lane * 64 + j]; else run += lf[lane * 64 + j]; if (!(MK_DBG & 1024)) bk[j] = -run * INV_SM_SCALE; }
        }
        __syncthreads();
    }
}

__device__ __forceinline__ void p4_qa_fixup(Frame& F, ArgsP a) {
    const int lane = F.lane, dl = (lane & 15) * 8; bf16_t* QA = (bf16_t*)(a->ws + WS_RA);
    const float* ca = (const float*)(a->ws + WS_ROPEA); const float* sa = ca + (size_t)M * 64; const float* gqa = (const float*)a->in[I_GQA];
    const f32x4 g0 = *(const f32x4*)(gqa + dl), g1 = *(const f32x4*)(gqa + dl + 4); const bool hi = (lane & 8) != 0;
    for (int m = F.gw; m < M; m += F.NGW) { u32x4* p = (u32x4*)(QA + (size_t)m * 2048) + lane;
        u32x4 w[4];
#pragma unroll
        for (int c = 0; c < 4; ++c) w[c] = p[64 * c];
        const f32x4 c0 = *(const f32x4*)(ca + (size_t)m * 64 + (dl & 63)), c1 = *(const f32x4*)(ca + (size_t)m * 64 + (dl & 63) + 4);
        f32x4 s0 = *(const f32x4*)(sa + (size_t)m * 64 + (dl & 63)), s1 = *(const f32x4*)(sa + (size_t)m * 64 + (dl & 63) + 4);
        asm volatile("" ::: "memory");
        if (!hi) { s0 = -s0; s1 = -s1; }
#pragma unroll
        for (int c = 0; c < 4; ++c) { f32x4 x0, x1; pg8::unpack8f(w[c], x0, x1);
            float ss = 0.f;
#pragma unroll
            for (int j = 0; j < 4; ++j) ss += x0[j] * x0[j] + x1[j] * x1[j];
            ss += __shfl_xor(ss, 1); ss += __shfl_xor(ss, 2); ss += __shfl_xor(ss, 4); ss += __shfl_xor(ss, 8);
            const float rstd = 1.0f / sqrtf(ss * (1.f / 128.f) + EPS);
            x0 = x0 * rstd * g0; x1 = x1 * rstd * g1;
            f32x4 y0, y1;
#pragma unroll
            for (int j = 0; j < 4; ++j) { y0[j] = __shfl_xor(x0[j], 8); y1[j] = __shfl_xor(x1[j], 8); }
            p[64 * c] = pg8::pack8f(x0 * c0 + y0 * s0, x1 * c1 + y1 * s1); } }
}

__device__ __forceinline__ int wave_sum_i32(int v) {
    v += __builtin_amdgcn_update_dpp(0, v, 0x111, 0xf, 0xf, true);
    v += __builtin_amdgcn_update_dpp(0, v, 0x112, 0xf, 0xf, true);
    v += __builtin_amdgcn_update_dpp(0, v, 0x114, 0xf, 0xf, true);
    v += __builtin_amdgcn_update_dpp(0, v, 0x118, 0xf, 0xf, true);
    return __builtin_amdgcn_readlane(v, 15) + __builtin_amdgcn_readlane(v, 31) + __builtin_amdgcn_readlane(v, 47) + __builtin_amdgcn_readlane(v, 63);
}
__device__ __forceinline__ unsigned sortable_u(float v) { const unsigned b = __float_as_uint(v); return (b & 0x80000000u) ? ~b : (b | 0x80000000u); }
__device__ __forceinline__ void indexer_query(Frame& F, ArgsP a, int b, int t) {
    const int lane = F.lane, n = lane & 31, kg = lane >> 5;
    const size_t row = (size_t)b * SEQ + t;
    const int nt = (t >> 6) + 1;
    LAS float* sc = (LAS float*)(F.lds + F.wave * 16384);
    const bf16_t* QI = (const bf16_t*)(a->ws + WS_RA) + (size_t)M * 2048; const bf16_t* KIDX = (const bf16_t*)(a->ws + WS_KIDX);
    const float* WIDX = (const float*)(a->ws + WS_WIDX); const float* ci = (const float*)(a->ws + WS_ROPEI); const float* si = ci + (size_t)M * 16;
    unsigned long long* SELM = (unsigned long long*)(a->ws + WS_SELM);
    bf16x8 af[4];
    { const bf16_t* qp = QI + row * 2048 + n * 64 + kg * 32;
#pragma unroll
      for (int s = 0; s < 4; ++s) af[s] = *(const bf16x8*)(qp + 8 * s);
      float x[32];
#pragma unroll
      for (int s = 0; s < 4; ++s)
#pragma unroll
          for (int j = 0; j < 8; ++j) x[8 * s + j] = bf2f((unsigned short)af[s][j]);
      const f32x4* c4 = (const f32x4*)(ci + row * 16); const f32x4* s4 = (const f32x4*)(si + row * 16);
      float y[32];
#pragma unroll
      for (int q = 0; q < 4; ++q) { const f32x4 cc = c4[q], ss = s4[q];
#pragma unroll
          for (int j = 0; j < 4; ++j) { const int i = 4 * q + j; y[i] = x[i] * cc[j] - x[i + 16] * ss[j]; y[i + 16] = x[i + 16] * cc[j] + x[i] * ss[j]; } }
      if (kg == 0) {
#pragma unroll
          for (int s = 0; s < 4; ++s) { u32x4 w; w.x = pk2(y[8 * s], y[8 * s + 1]); w.y = pk2(y[8 * s + 2], y[8 * s + 3]); w.z = pk2(y[8 * s + 4], y[8 * s + 5]); w.w = pk2(y[8 * s + 6], y[8 * s + 7]);
              af[s] = *reinterpret_cast<bf16x8*>(&w); } } }
    typedef float f32x2_t __attribute__((ext_vector_type(2)));
    f32x2_t wp2[8];
    { const float* wp = WIDX + row * 32 + 4 * kg;
#pragma unroll
      for (int j = 0; j < 4; ++j) { const f32x4 w = *(const f32x4*)(wp + 8 * j); wp2[2 * j] = (f32x2_t){w[0], w[1]}; wp2[2 * j + 1] = (f32x2_t){w[2], w[3]}; } }
    const bf16_t* kp = KIDX + (size_t)b * SEQ * 64 + lane * 8;
#define IDX_MMA(BX, cA, cB) do { _Pragma("unroll") for (int s = 0; s < 4; ++s) { cA = __builtin_amdgcn_mfma_f32_32x32x16_bf16(af[s], BX[s], cA, 0, 0, 0); cB = __builtin_amdgcn_mfma_f32_32x32x16_bf16(af[s], BX[4 + s], cB, 0, 0, 0); } } while (0)
#define IDX_SUM(cA, cB, i_) do { f32x2_t aA = {0.f, 0.f}, aB = {0.f, 0.f}; \
        _Pragma("unroll") for (int j = 0; j < 8; ++j) { \
            f32x2_t rA, rB; rA.x = __int_as_float(max(__float_as_int(cA[2 * j]), 0)); rA.y = __int_as_float(max(__float_as_int(cA[2 * j + 1]), 0)); \
            rB.x = __int_as_float(max(__float_as_int(cB[2 * j]), 0)); rB.y = __int_as_float(max(__float_as_int(cB[2 * j + 1]), 0)); \
            aA = __builtin_elementwise_fma(wp2[j], rA, aA); aB = __builtin_elementwise_fma(wp2[j], rB, aB); } \
        const float sA = aA.x + aA.y, sB = aB.x + aB.y; \
        auto rr = __builtin_amdgcn_permlane32_swap(__float_as_uint(sA), __float_as_uint(sB), false, false); \
        sc[(i_) * 64 + lane] = __uint_as_float(sortable_u(__uint_as_float(rr[0]) + __uint_as_float(rr[1]))); } while (0)
#define IDX_LOAD(BX, i_) do { const bf16_t* kn_ = kp + (size_t)(i_) * 4096; \
        _Pragma("unroll") for (int s = 0; s < 4; ++s) { BX[s] = *(const bf16x8*)(kn_ + 512 * s); BX[4 + s] = *(const bf16x8*)(kn_ + 2048 + 512 * s); } } while (0)
    bf16x8 bX[8], bY[8];
    IDX_LOAD(bX, 0); IDX_LOAD(bY, nt > 1 ? 1 : 0);
    for (int i = 0; i < nt; i += 2) {
        f32x16 cA = {}, cB = {}, cC = {}, cD = {};
        IDX_MMA(bX, cA, cB); IDX_LOAD(bX, i + 2 < nt ? i + 2 : nt - 1);
        IDX_MMA(bY, cC, cD); IDX_LOAD(bY, i + 3 < nt ? i + 3 : nt - 1);
        IDX_SUM(cA, cB, i); IDX_SUM(cC, cD, i + 1);
    }
#undef IDX_MMA
#undef IDX_SUM
#undef IDX_LOAD
    unsigned u[64];
#pragma unroll
    for (int i = 0; i < 64; ++i) u[i] = __float_as_uint(sc[i * 64 + lane]);
    asm volatile("" ::: "memory");
#pragma unroll
    for (int i = 0; i < 64; ++i) u[i] = (i < nt) ? u[i] : 0u;
    unsigned mlo = 0u, mhi = 0u;
    if (nt <= TOPK / 64) { if (lane < nt) { mlo = 0xffffffffu; mhi = 0xffffffffu; } }
    else {
        unsigned T = 0u;
        for (int bit = 31; bit >= 0; --bit) {
            const unsigned cand = T | (1u << bit); int cl = 0;
#pragma unroll
            for (int g = 0; g < 8; ++g) { if (g * 8 < nt) {
#pragma unroll
                for (int i = 0; i < 8; ++i) cl += (u[g * 8 + i] >= cand) ? 1 : 0; }
                __builtin_amdgcn_sched_barrier(0); }
            const int c = wave_sum_i32(cl);
            if (c >= TOPK) { T = cand; if (c == TOPK) break; }
        }
        int cgt = 0;
#pragma unroll
        for (int g = 0; g < 8; ++g) { if (g * 8 < nt) {
#pragma unroll
            for (int i = 0; i < 8; ++i) cgt += __popcll(__ballot(u[g * 8 + i] > T)); }
            __builtin_amdgcn_sched_barrier(0); }
        int need = TOPK - cgt;
#pragma unroll
        for (int g = 0; g < 8; ++g) { if (g * 8 < nt) {
#pragma unroll
            for (int i8 = 0; i8 < 8; ++i8) { const int i = g * 8 + i8;
                unsigned long long mk = __ballot(u[i] > T); unsigned long long eq = __ballot(u[i] == T);
                if (eq) { int ce = __popcll(eq);
                    if (ce > need) { int drop = ce - need; while (drop-- > 0) eq &= ~(1ull << (63 - __clzll((long long)eq))); ce = need; }
                    need -= ce; mk |= eq; }
                if (lane == i) { mlo = (unsigned)mk; mhi = (unsigned)(mk >> 32); } } }
            __builtin_amdgcn_sched_barrier(0); }
    }
    SELM[row * 64 + lane] = ((unsigned long long)mhi << 32) | mlo;
}

__device__ __forceinline__ void naive_attn_row(int lane, const bf16_t* q, const bf16_t* K, const bf16_t* V, int pitch, int nk, const float* bias, const unsigned long long* msk, bf16_t* out, LAS float* pl, const float* lfp = nullptr, float bfv = 0.f) {
    u32x4 qv[16];
#pragma unroll
    for (int i = 0; i < 16; ++i) qv[i] = *(const u32x4*)(q + 8 * i);
    float mx = -3.0e38f; float carry = 0.f;
    for (int c = 0; c * 64 < nk; ++c) { const int sk = c * 64 + lane; bool valid = sk < nk; if (msk) valid = valid && ((msk[c] >> lane) & 1ull);
        float fb = 0.f;
        if (lfp) { const float xx = lfp[(size_t)sk * 256] + bfv; float inc = fminf(xx, 0.f) - log1pf(expf(-fabsf(xx)));
            for (int o = 1; o < 64; o <<= 1) { const float tt = __shfl_up(inc, o); if (lane >= o) inc += tt; }
            fb = -(carry + inc) * INV_SM_SCALE; carry += __shfl(inc, 63); }
        float dot = 0.f;
        if (sk < nk) { const u32x4* kr = (const u32x4*)(K + (size_t)sk * pitch);
#pragma unroll
            for (int i = 0; i < 16; ++i) { const u32x4 kv = kr[i];
                dot += bflo(qv[i].x) * bflo(kv.x) + bfhi(qv[i].x) * bfhi(kv.x) + bflo(qv[i].y) * bflo(kv.y) + bfhi(qv[i].y) * bfhi(kv.y)
                     + bflo(qv[i].z) * bflo(kv.z) + bfhi(qv[i].z) * bfhi(kv.z) + bflo(qv[i].w) * bflo(kv.w) + bfhi(qv[i].w) * bfhi(kv.w); } }
        float lg = valid ? (dot + (lfp ? fb : (bias ? bias[sk] : 0.f))) * SM_SCALE : -3.0e38f;
        pl[c * 64 + lane] = lg; mx = fmaxf(mx, lg); }
#pragma unroll
    for (int o = 1; o < 64; o <<= 1) mx = fmaxf(mx, __shfl_xor(mx, o));
    float ls = 0.f;
    for (int c = 0; c * 64 < nk; ++c) { const float lg = pl[c * 64 + lane]; const float p = lg > -1.0e38f ? __expf(lg - mx) : 0.f; pl[c * 64 + lane] = p; ls += p; }
    ls = wave_sum(ls);
    asm volatile("s_waitcnt lgkmcnt(0)" ::: "memory");
    float o0 = 0.f, o1 = 0.f; const int nkr = ((nk + 63) / 64) * 64;
    for (int sk = 0; sk < nkr && sk < nk; ++sk) { const float p = pl[sk]; const unsigned vv = *(const unsigned*)(V + (size_t)sk * pitch + 2 * lane); o0 += p * bflo(vv); o1 += p * bfhi(vv); }
    const float inv = 1.0f / ls;
    *(unsigned*)(out + 2 * lane) = pk2(o0 * inv, o1 * inv);
}
__device__ __forceinline__ void dbg_check_proj(Frame& F, ArgsP a) {
    const int lane = F.lane; LAS float* hv = (LAS float*)(F.lds + F.wave * 16384);
    const float* X_ = (const float*)a->in[I_X]; const float* W = (const float*)a->in[I_WIN]; const float* ga = (const float*)a->in[I_GATTN];
    unsigned* flag = (unsigned*)(a->ws + WS_CTL) + 8;
    const bf16_t* QB = (const bf16_t*)(a->ws + WS_RD); const bf16_t* KB = QB + (size_t)M * 2048; const bf16_t* VB = KB + (size_t)M * 2048; const bf16_t* GT = (const bf16_t*)(a->ws + WS_RG);
    const float* gqb = (const float*)a->in[I_GQB]; const float* gkb = (const float*)a->in[I_GKB];
    if (MK_CHECK & 2) { const bf16_t* W1T = (const bf16_t*)(a->ws + WS_RB);
        for (int it = F.gw; it < 64; it += F.NGW) { const int half = it & 1, n = 7936 + 256 * (it >> 1) + 128 * half + 5 * (it >> 1) % 128; const int src = 7792 + (n - 7936);
            bool bad = false;
            for (int k = lane; k < DM; k += 64) { const unsigned short e = (unsigned short)f2bf(W[(size_t)k * INW + src]); if (e != W1T[(size_t)n * DM + k]) bad = true; }
            if (__any(bad) && lane == 0) atomicOr(flag, half ? 256u : 128u); } }
    for (int smp = F.gw; smp < 256; smp += F.NGW) { const int m = smp * 64 + (smp * 7) % 61;
        float ss = 0.f; for (int k = lane; k < DM; k += 64) { const float v = X_[(size_t)m * DM + k]; ss += v * v; }
        const float rstd = 1.0f / sqrtf(wave_sum(ss) * (1.f / DM) + EPS);
        for (int k = lane; k < DM; k += 64) hv[k] = bf2f((unsigned short)f2bf(X_[(size_t)m * DM + k] * rstd * ga[k]));
        asm volatile("s_waitcnt lgkmcnt(0)" ::: "memory");
#pragma unroll 1
        for (int gI = 0; gI < 6; ++gI) { float a0 = 0.f, a1 = 0.f;
            const int scol = gI == 0 ? 0 : gI == 1 ? 128 : gI == 2 ? 1632 + 256 : gI == 3 ? 1632 + 2048 + 1024 : gI == 4 ? 1632 + 4096 : 1024;
            const float* wp = W + scol + 2 * lane;
#pragma unroll 2
            for (int k = 0; k < DM; ++k) { const float hk = hv[k]; const f32x2 w2 = *(const f32x2*)(wp + (size_t)k * INW); a0 += hk * bf2f((unsigned short)f2bf(w2.x)); a1 += hk * bf2f((unsigned short)f2bf(w2.y)); }
            const float e0 = a0, e1 = a1;
            const bf16_t* gp = gI == 0 ? (const bf16_t*)(a->ws + WS_RC) + (size_t)m * 1024 : gI == 1 ? (const bf16_t*)(a->ws + WS_RC) + (size_t)m * 1024 + 128 : gI == 2 ? QB + (size_t)m * 2048 + 256 : gI == 3 ? KB + (size_t)m * 2048 + 1024 : gI == 4 ? VB + (size_t)m * 2048 : (const bf16_t*)(a->ws + WS_KVA) + (size_t)m * 512;
            const unsigned got = *(const unsigned*)(gp + 2 * lane); const float g0 = bflo(got), g1 = bfhi(got);
            const bool bad = fabsf(g0 - e0) > 0.03f + 0.02f * fabsf(e0) || fabsf(g1 - e1) > 0.03f + 0.02f * fabsf(e1);
            if (__any(bad) && lane == 0) atomicOr(flag, 1u << gI); }
    }
}
__device__ __forceinline__ int snake(int j, int w, int G) { return j * G + ((j & 1) ? (G - 1 - w) : w); }
__device__ __forceinline__ int q_grab(Frame& F, unsigned* head, int& par) {
    if (F.tid == 0) F.MISC[32 + par] = atomicAdd(head, 1u);
    __syncthreads();
    const int v = (int)F.MISC[32 + par]; par ^= 1; return v;
}
__device__ __forceinline__ fa::Ref fox_ref(int L, bf16_t* RD, const float* biasK, float thr, int lane) {
    const int qb = 15 - (L >> 6), bh = L & 63, b = bh >> 4, h = bh & 15; fa::Ref r;
    const size_t base = (size_t)b * SEQ * 2048 + (size_t)h * 128;
    const float* bp = biasK + (size_t)bh * SEQ; const int t0 = qb * 256, nj = qb * 4;
    const float bt = bp[t0], bj = bp[64 * (lane < nj ? lane : 0) + 63];
    const unsigned long long sk = __ballot(lane < nj && (bt - bj) * SM_SCALE > thr);
    const int T0 = sk == ~0ull ? 64 : __builtin_ctzll(~sk);
    r.Q = RD + base + (size_t)qb * 256 * 2048; r.O = RD + base + (size_t)qb * 256 * 2048;
    r.K = RD + (size_t)M * 2048 + base + (size_t)T0 * 64 * 2048; r.V = RD + (size_t)2 * M * 2048 + base + (size_t)T0 * 64 * 2048;
    r.bias = bp + T0 * 64; r.msk = nullptr; r.P0 = t0 - T0 * 64; r.NT = (qb + 1) * 4 - T0; return r;
}
__device__ __forceinline__ fa::Ref dsa_ref(int L, bf16_t* RA, const bf16_t* KVA, const unsigned long long* SELM) {
    const int c = 63 - (L >> 4), r = L & 15, b = r >> 2, g = (r >> 1) & 1, hf = r & 1; const int t0 = c * 64 + hf * 32; fa::Ref q;
    q.Q = RA + ((size_t)b * SEQ + t0) * 2048 + (size_t)g * 8 * 128; q.O = RA + (size_t)M * 2048 + ((size_t)b * SEQ + t0) * 2048 + (size_t)g * 8 * 128;
    q.K = KVA + (size_t)b * SEQ * 512 + (size_t)g * 128; q.V = KVA + (size_t)b * SEQ * 512 + 256 + (size_t)g * 128;
    q.bias = nullptr; q.msk = SELM + ((size_t)b * SEQ + t0) * 64; q.P0 = 0; q.NT = c + 1; return q;
}

constexpr int NPH = 13;
__global__ void __launch_bounds__(NWAVES * 64, 2) mk_fwd(Args args) {
    extern __shared__ __attribute__((aligned(16))) unsigned char lds[];
    Frame F;
    F.lds = (LAS unsigned char*)lds; F.ldsg = (char*)lds;
    F.MISC = (volatile LAS unsigned*)(F.lds + MISC_OFF);
    F.tid = threadIdx.x; F.lane = F.tid & 63; F.wave = __builtin_amdgcn_readfirstlane(F.tid >> 6);
    F.G = gridDim.x; { const int bx = blockIdx.x; F.vcu = (F.G % 8 == 0) ? (bx % 8) * (F.G / 8) + bx / 8 : bx; }
    F.gw = F.vcu * NWAVES + F.wave; F.NGW = F.G * NWAVES;
    ArgsP a = get_args();
    unsigned* ctl = (unsigned*)(a->ws + WS_CTL);
    for (int u = F.tid; u < (LDS_BYTES - LDSCTL_OFF) / 4; u += NWAVES * 64) ((LAS unsigned*)(F.lds + LDSCTL_OFF))[u] = 0u;
    __syncthreads();
    XcdBarrier bar; bar.bar = ctl + CW_BAR; bar.x = 0; bar.st = nullptr;
    if (MK_N_LAUNCHES == 1) bar = xcd_barrier_post(ctl + CW_BAR, F.MISC + 8);
    const int lo = a->ph_lo, hi = a->ph_hi;
#define IN(k) (((MK_PHASE_MASK >> (k)) & 1) && lo <= (k) && (k) < hi)
#define SEAM(k) do { if (IN(k) && IN((k) + 1)) xcd_barrier(bar); } while (0)
#define X ((const float*)a->in[I_X])
#define OUT ((float*)a->out)
#define RA ((bf16_t*)(a->ws + WS_RA))
#define RB ((bf16_t*)(a->ws + WS_RB))
#define RC ((bf16_t*)(a->ws + WS_RC))
#define RD ((bf16_t*)(a->ws + WS_RD))
#define RG ((bf16_t*)(a->ws + WS_RG))
#define KVA ((bf16_t*)(a->ws + WS_KVA))

    if (MK_CHECK && lo == 100) { a = get_args(); dbg_check_proj(F, a); return; }

    if (IN(0)) { a = get_args(); p0_prologue(F, a); } SEAM(0);

    if (IN(1)) { a = get_args();
        pg8::Gemm g{RA, RB, nullptr, nullptr, M, N1, DM}; pg8::StaticOrder S; S.init(M, N1, F.G, (int)blockIdx.x);
        pg8::EpiP1 E{RC, KVA, RD, RG, (float*)(a->ws + WS_MISC), (const float*)a->in[I_GQB], (const float*)a->in[I_GKB], (LAS float*)(F.lds + RING_BYTES)};
        pg8::gemm_phase<pg8::EpiP1, pg8::StaticOrder>(F.lds, g, S, E);
        { const int rem = S.nwg % F.G, c = (int)blockIdx.x;
          if (rem == 0) tr_convert(F, a, TR_A, TR_B, c * NWAVES + F.wave, F.G * NWAVES);
          else if (c >= rem) tr_convert(F, a, TR_A, TR_B, (c - rem) * NWAVES + F.wave, (F.G - rem) * NWAVES); }
    } SEAM(1);

    if (IN(2)) { a = get_args(); if (MK_DBG & 512) { for (int q = 0; q < 600; ++q) __builtin_amdgcn_s_sleep(127); } p2_fixups(F, a); } SEAM(2);

    if (IN(3)) { a = get_args();
        pg8::Gemm g{RC, (const bf16_t*)(a->ws + WS_W3T), nullptr, nullptr, M, 4096, QRANK}; pg8::StaticOrder S; S.init(M, 4096, F.G, (int)blockIdx.x);
        pg8::EpiBf16 E{RA, 2048, 2048, (size_t)M * 2048};
        pg8::gemm_phase<pg8::EpiBf16, pg8::StaticOrder>(F.lds, g, S, E);
        if (MK_NAIVE & 1) { LAS float* pl = (LAS float*)(F.lds + F.wave * 16384); constexpr int NHN = 4; bf16_t* TMP = RB; const float* biasK = (const float*)(a->ws + WS_BIASK);
            for (int it = F.gw; it < M * NHN; it += F.NGW) { const int m = it / NHN, h = it % NHN, b = m / SEQ, t = m % SEQ;
                const bf16_t* qp = RD + (size_t)m * 2048 + h * 128; const size_t kb = (size_t)b * SEQ * 2048 + h * 128;
                naive_attn_row(F.lane, qp, RD + (size_t)M * 2048 + kb, RD + (size_t)2 * M * 2048 + kb, 2048, t + 1, biasK + (size_t)(b * NH + h) * SEQ, nullptr, TMP + (size_t)m * 512 + h * 128, pl,
                    (const float*)(a->ws + WS_MISC) + (size_t)b * SEQ * 256 + 96 + h, ((const float*)a->in[I_BFORGET])[h]); } }
    } SEAM(3);

    if (IN(4)) { a = get_args();
        if (MK_DBG & 8) { for (int u = 135168 / 4 + F.tid; u < LDS_BYTES / 4; u += NWAVES * 64) ((LAS unsigned*)F.lds)[u] = 0u; __syncthreads(); }
        if (MK_DBG & 16) { for (int q = 0; q < 64; ++q) __builtin_amdgcn_s_sleep(64); }
        if (MK_ATTN & 1) {
            const float* biasK = (const float*)(a->ws + WS_BIASK);
            float thr;
            { const float* gq = (const float*)a->in[I_GQB]; const float* gk = (const float*)a->in[I_GKB];
              float mq = fmaxf(fabsf(gq[F.lane]), fabsf(gq[F.lane + 64])), mk_ = fmaxf(fabsf(gk[F.lane]), fabsf(gk[F.lane + 64]));
#pragma unroll
              for (int o = 1; o < 64; o <<= 1) { mq = fmaxf(mq, __shfl_xor(mq, o)); mk_ = fmaxf(mk_, __shfl_xor(mk_, o)); }
              thr = 2.0f * 11.313708499f * 1.03f * mq * mk_ + 96.0f; }
#define mkref(L) fox_ref((L), RD, biasK, thr, F.lane)
            { unsigned* qh = (unsigned*)(a->ws + WS_CTL) + CW_QFOX; int par = 0;
              const int L0 = q_grab(F, qh, par);
              if (L0 < 1024) { fa::Seam S; fa::Ref cur = mkref(L0);
                  fa::prime<0>(cur, F.ldsg, S);
                  for (;;) { const int Ln = q_grab(F, qh, par); const bool has = Ln < 1024; const fa::Ref nxt = has ? mkref(Ln) : cur;
                      fa::block<0>(cur, nxt, F.ldsg, S); if (!has) break; cur = nxt; } } }
#undef mkref
        } else if (!(MK_ATTN & 4)) {
            u32x4* z = (u32x4*)RD; const u32x4 zz = {0u, 0u, 0u, 0u};
            for (size_t i = (size_t)blockIdx.x * 512 + F.tid; i < (size_t)M * 2048 / 8; i += (size_t)F.G * 512) z[i] = zz;
        }
        if (MK_ATTN & 2) {
            const int NR = 2048 / F.G;
            if (MK_DBG & 1) { unsigned long long* sm = (unsigned long long*)(a->ws + WS_SELM);
                for (size_t i = (size_t)blockIdx.x * 512 + F.tid; i < (size_t)M * 64; i += (size_t)F.G * 512) sm[i] = ~0ull; }
            else
            { unsigned* qh = (unsigned*)(a->ws + WS_CTL) + CW_QIDX; int par = 0;
              int L = q_grab(F, qh, par);
              while (L < 2048) { unsigned tok = 0u; if (F.tid == 0) tok = atomicAdd(qh, 1u);
                  { const int c = 63 - (L >> 5), r = L & 31, b = r >> 3, oc = r & 7; indexer_query(F, a, b, c * 64 + oc * 8 + F.wave); }
                  if (F.tid == 0) F.MISC[32 + par] = tok;
                  __syncthreads(); L = (int)F.MISC[32 + par]; par ^= 1; } }
            p4_qa_fixup(F, a);
        }
        if (MK_ATTN & 4) p4_qa_fixup(F, a);
        if (MK_DBG & 32) { const float* bk = (const float*)(a->ws + WS_BIASK);
            for (int it = F.gw; it < M * NH; it += F.NGW) { const int m = it >> 4, h = it & 15, b = m / SEQ, t = m % SEQ;
                const float v = (MK_DBG & 4096) ? ((const float*)a->in[I_BFORGET])[h] : (MK_DBG & 64) ? ((const float*)(a->ws + WS_MISC))[(size_t)m * 256 + 96 + h] : bk[(size_t)(b * NH + h) * SEQ + t] * 1e-3f; *(unsigned*)(RD + (size_t)m * 2048 + h * 128 + 2 * F.lane) = pk2(v, -v); } }
    } SEAM(4);

    if (IN(5)) { a = get_args();
        if (MK_NAIVE & 1) { constexpr int NHN = 4; const bf16_t* TMP = RB;
            for (int it = F.gw; it < M * NHN; it += F.NGW) { const int m = it / NHN, h = it % NHN;
                *(unsigned*)(RD + (size_t)m * 2048 + h * 128 + 2 * F.lane) = *(const unsigned*)(TMP + (size_t)m * 512 + h * 128 + 2 * F.lane); } }
        if (MK_DBG & 4) { for (int u = 135168 / 4 + F.tid; u < LDS_BYTES / 4; u += NWAVES * 64) ((LAS unsigned*)F.lds)[u] = 0u; __syncthreads(); }
        if (MK_ATTN & 2) {
            const unsigned long long* SELM = (const unsigned long long*)(a->ws + WS_SELM);
#define mkref(L) dsa_ref((L), RA, KVA, SELM)
            const int NR = 1024 / F.G;
            if (NR * F.G == 1024) {
                if (MK_NAIVE & 2) { LAS float* pl = (LAS float*)(F.lds + F.wave * 16384);
                    for (int it = F.gw; it < M * 8; it += F.NGW) { const int m = it >> 3, h = it & 7, b = m / SEQ, t = m % SEQ;
                        const bf16_t* kv = KVA + (size_t)b * SEQ * 512;
                        naive_attn_row(F.lane, RA + (size_t)m * 2048 + h * 128, kv, kv + 256, 512, ((t >> 6) + 1) * 64, nullptr, SELM + (size_t)m * 64, RA + (size_t)M * 2048 + (size_t)m * 2048 + h * 128, pl); }
                    __syncthreads();
                    for (int j = 0; j < NR; ++j) { const int L = snake(j, (int)blockIdx.x, F.G); if (((L >> 1) & 1) == 1) { const fa::Ref cur = mkref(L); fa::sblock<1>(cur, F.ldsg); } } }
                else if (MK_SIMPLE) { for (int j = 0; j < NR; ++j) { const fa::Ref cur = mkref(snake(j, (int)blockIdx.x, F.G)); fa::sblock<1>(cur, F.ldsg); } }
                else {
                fa::Seam S; fa::Ref cur = mkref(snake(0, (int)blockIdx.x, F.G));
                fa::prime<1>(cur, F.ldsg, S);
                for (int j = 0; j < NR; ++j) { const fa::Ref nxt = (j + 1 < NR) ? mkref(snake(j + 1, (int)blockIdx.x, F.G)) : cur;
                    fa::block<1>(cur, nxt, F.ldsg, S); cur = nxt; } }
            }
#undef mkref
        } else if (!(MK_ATTN & 4)) {
            u32x4* z = (u32x4*)(RA + (size_t)M * 2048); const u32x4 zz = {0u, 0u, 0u, 0u};
            for (size_t i = (size_t)blockIdx.x * 512 + F.tid; i < (size_t)M * 2048 / 8; i += (size_t)F.G * 512) z[i] = zz;
        }
    } SEAM(5);

    if (IN(6)) { a = get_args();
        pg8::Gemm g{(MK_ATTN & 8) ? RD + (size_t)M * 2048 : RA + (size_t)M * 2048, (const bf16_t*)(a->ws + WS_WUPA), (MK_ATTN & 8) ? RD + (size_t)2 * M * 2048 : RD, (const bf16_t*)(a->ws + WS_WUPB), M, DM, 2048}; pg8::DualOrder S; S.init(M, DM, F.G, (int)blockIdx.x);
        pg8::EpiMerge E{RG, (MK_ATTN & 8) ? RA : RD + (size_t)M * 2048, RB};
        pg8::gemm_phase<pg8::EpiMerge, pg8::DualOrder>(F.lds, g, S, E);
    } SEAM(6);

    if (IN(7)) { a = get_args();
        pg8::Gemm g{RB, (const bf16_t*)(a->ws + WS_WO), nullptr, nullptr, M, DM, DM}; pg8::StaticOrder S; S.init(M, DM, F.G, (int)blockIdx.x);
        pg8::EpiResidNorm<false> E{X, (bf16_t*)(a->ws + WS_H2), (float*)(a->ws + WS_SS)};
        pg8::gemm_phase<pg8::EpiResidNorm<false>, pg8::StaticOrder>(F.lds, g, S, E);
        tr_convert(F, a, TR_B, TR_C, F.gw, F.NGW);
    } SEAM(7);

    if (IN(9)) { a = get_args();
        pg8::Gemm g{(const bf16_t*)(a->ws + WS_H2), (const bf16_t*)(a->ws + WS_WGU), nullptr, nullptr, M, 2 * DFF, DM}; pg8::StaticOrder S; S.init(M, 2 * DFF, F.G, (int)blockIdx.x);
        pg8::EpiSwiGLU E{(bf16_t*)(a->ws + WS_ACT), (const float*)(a->ws + WS_SS)};
        pg8::gemm_phase<pg8::EpiSwiGLU, pg8::StaticOrder>(F.lds, g, S, E);
        { const int rem = S.nwg % F.G, c = (int)blockIdx.x;
          if (rem == 0) tr_convert(F, a, TR_C, TR_D, c * NWAVES + F.wave, F.G * NWAVES);
          else if (c >= rem) tr_convert(F, a, TR_C, TR_D, (c - rem) * NWAVES + F.wave, (F.G - rem) * NWAVES); }
    } SEAM(9);

    if (IN(10)) { a = get_args();
        { pg8::Gemm g{(const bf16_t*)(a->ws + WS_ACT), (const bf16_t*)(a->ws + WS_WD), nullptr, nullptr, M, DM, DFF}; pg8::StaticOrder S; S.init(M, DM, F.G, (int)blockIdx.x);
          pg8::EpiResidNorm<true> E{(const bf16_t*)(a->ws + WS_H2), (bf16_t*)(a->ws + WS_H2), (float*)(a->ws + WS_SS) + M};
          pg8::gemm_phase<pg8::EpiResidNorm<true>, pg8::StaticOrder>(F.lds, g, S, E); }
        { pg8::Gemm g{(const bf16_t*)(a->ws + WS_PBF), (const bf16_t*)(a->ws + WS_WPLET), nullptr, nullptr, M, DM, PLE}; pg8::StaticOrder S; S.init(M, DM, F.G, (int)blockIdx.x);
          pg8::EpiBf16 E{(bf16_t*)(a->ws + WS_E), DM, 0, 0};
          pg8::gemm_phase<pg8::EpiBf16, pg8::StaticOrder>(F.lds, g, S, E); }
    } SEAM(10);

    if (IN(12)) { a = get_args();
        pg8::Gemm g{(const bf16_t*)(a->ws + WS_H2), (const bf16_t*)(a->ws + WS_WPG), nullptr, nullptr, M, DM, DM}; pg8::StaticOrder S; S.init(M, DM, F.G, (int)blockIdx.x);
        pg8::EpiPle E{(const bf16_t*)(a->ws + WS_E), (const bf16_t*)(a->ws + WS_H2), OUT, (const float*)(a->ws + WS_SS) + M};
        pg8::gemm_phase<pg8::EpiPle, pg8::StaticOrder>(F.lds, g, S, E);
    }
#undef IN
#undef SEAM
#undef X
#undef OUT
#undef RA
#undef RB
#undef RC
#undef RD
#undef RG
#undef KVA
}

extern "C" void kernel_launch(void* const* d_in, const int* in_sizes, int n_in, void* d_out, int out_size, void* d_ws, size_t ws_size, hipStream_t stream) {
    static int grid = 0;
    if (grid == 0) {
        if (n_in != 25 || in_sizes[0] != M * DM || out_size != M * DM || ws_size < WS_END) {
            fprintf(stderr, "kernel_launch: shape / workspace mismatch (n_in %d, in0 %d, out %d, ws %zu, need %zu); nothing launched\n", n_in, n_in > 0 ? in_sizes[0] : -1, out_size, ws_size, (size_t)WS_END); grid = -1; return; }
        int dev = 0, cus = 0, per_cu = 0;
        if (hipGetDevice(&dev) != hipSuccess || hipDeviceGetAttribute(&cus, hipDeviceAttributeMultiprocessorCount, dev) != hipSuccess) { grid = -1; return; }
        if (hipFuncSetAttribute((const void*)mk_fwd, hipFuncAttributeMaxDynamicSharedMemorySize, LDS_BYTES) != hipSuccess) { fprintf(stderr, "kernel_launch: hipFuncSetAttribute failed\n"); grid = -1; return; }
        if (hipOccupancyMaxActiveBlocksPerMultiprocessor(&per_cu, (const void*)mk_fwd, NWAVES * 64, LDS_BYTES) != hipSuccess || per_cu < 1)
            fprintf(stderr, "kernel_launch: occupancy query reports %d workgroups per CU\n", per_cu);
        (void)hipGetLastError();
        grid = cus;
        if (grid != 256) fprintf(stderr, "kernel_launch: %d CUs (built for 256)\n", grid);
    }
    if (grid < 0) return;
    if (hipMemsetAsync((char*)d_ws + WS_CTL, 0, CTL_ZERO_BYTES, stream) != hipSuccess) return;
    Args a{};
    for (int i = 0; i < 25; ++i) a.in[i] = d_in[i];
    a.out = (float*)d_out; a.ws = (unsigned char*)d_ws;
    if (MK_N_LAUNCHES == 1) { a.ph_lo = 0; a.ph_hi = NPH; hipLaunchKernelGGL(mk_fwd, dim3(grid), dim3(NWAVES * 64), LDS_BYTES, stream, a); }
    else for (int li = 0; li < NPH; ++li) { a.ph_lo = li; a.ph_hi = li + 1; hipLaunchKernelGGL(mk_fwd, dim3(grid), dim3(NWAVES * 64), LDS_BYTES, stream, a);
        if (MK_CHECK && li == 1) { a.ph_lo = 100; a.ph_hi = 101; hipLaunchKernelGGL(mk_fwd, dim3(grid), dim3(NWAVES * 64), LDS_BYTES, stream, a); } }
}
```

```cpp
#include <hip/hip_runtime.h>
#include <cstdio>
#include <cstdint>

#ifndef MK_N_LAUNCHES
#define MK_N_LAUNCHES 1
#endif
#ifndef MK_PHASE_MASK
#define MK_PHASE_MASK 0x1fff
#endif

#ifndef MK_P2MASK
#define MK_P2MASK 31
#endif
#ifndef MK_CHECK
#define MK_CHECK 0
#endif
#ifndef MK_NAIVE
#define MK_NAIVE 0
#endif
#ifndef MK_SIMPLE
#define MK_SIMPLE 0
#endif
#ifndef MK_DBG
#define MK_DBG 0
#endif
#ifndef MK_ATTN
#define MK_ATTN 3
#endif

#define LAS __attribute__((address_space(3)))
typedef unsigned short bf16_t;
typedef short bf16x8 __attribute__((ext_vector_type(8)));
typedef short s16x4 __attribute__((ext_vector_type(4)));
typedef float f32x2 __attribute__((ext_vector_type(2)));
typedef float f32x4 __attribute__((ext_vector_type(4)));
typedef float f32x16 __attribute__((ext_vector_type(16)));
typedef unsigned u32x2 __attribute__((ext_vector_type(2)));
typedef unsigned u32x4 __attribute__((ext_vector_type(4)));

constexpr int BATCH = 4, SEQ = 4096, DM = 4096, M = BATCH * SEQ;
constexpr int NH = 16, HD = 128, QRANK = 1024, NIH = 32, IDIM = 64, DFF = 11008, PLE = 256, TOPK = 256;
constexpr int INW = 15984;
constexpr int N1 = 16128;
constexpr float EPS = 1e-6f;
constexpr float SM_SCALE = 0.08838834764831845f;
constexpr float INV_SM_SCALE = 11.313708498984761f;

constexpr size_t MiB = 1u << 20;
constexpr size_t WS_CTL = 0, CTL_ZERO_BYTES = 1 * MiB;
constexpr size_t WS_W3T = 1 * MiB;
constexpr size_t WS_WPLET = WS_W3T + 8 * MiB;
constexpr size_t WS_WUPA = WS_WPLET + 2 * MiB;
constexpr size_t WS_WUPB = WS_WUPA + 16 * MiB;
constexpr size_t WS_WO = WS_WUPB + 16 * MiB;
constexpr size_t WS_ROPEA = WS_WO + 32 * MiB;
constexpr size_t WS_ROPEI = WS_ROPEA + 8 * MiB;
constexpr size_t WS_KIDX = WS_ROPEI + 2 * MiB;
constexpr size_t WS_WIDX = WS_KIDX + 2 * MiB;
constexpr size_t WS_BIASK = WS_WIDX + 2 * MiB;
constexpr size_t WS_SELM = WS_BIASK + 1 * MiB;
constexpr size_t WS_PBF = WS_SELM + 8 * MiB;
constexpr size_t WS_KVA = WS_PBF + 8 * MiB;
constexpr size_t WS_MISC = WS_KVA + 16 * MiB;
constexpr size_t WS_RA = WS_MISC + 16 * MiB;
constexpr size_t WS_RB = WS_RA + 128 * MiB;
constexpr size_t WS_RC = WS_RB + 126 * MiB;
constexpr size_t WS_RD = WS_RC + 32 * MiB;
constexpr size_t WS_RG = WS_RD + 192 * MiB;
constexpr size_t WS_WPG = WS_RG + 256 * MiB;
constexpr size_t WS_END = WS_WPG + 32 * MiB;
constexpr size_t WS_ACT = WS_RA;
constexpr size_t WS_WGU = WS_ACT + 344 * MiB;
constexpr size_t WS_WD = WS_WGU + 172 * MiB;
constexpr size_t WS_H2 = WS_RG + 128 * MiB;
constexpr size_t WS_E = WS_WGU;
constexpr size_t WS_SS = WS_CTL + 512 * 1024;
static_assert(WS_RB - WS_RA == (size_t)M * DM * 2 && WS_RC - WS_RB >= (size_t)N1 * DM * 2 && WS_RD - WS_RC == (size_t)M * QRANK * 2, "ws map");
static_assert(WS_RG - WS_RD == (size_t)3 * M * 2048 * 2 && WS_WGU >= WS_RD + (size_t)M * 2048 * 2 * 0 && WS_WD + 86 * MiB <= WS_H2 && WS_END <= 1024 * MiB, "ws map 2");
static_assert(WS_ACT + (size_t)M * DFF * 2 <= WS_WGU, "act vs WGU");
constexpr int CW_BAR = 4096;
constexpr int CW_QFOX = 8192, CW_QIDX = 8193;

constexpr int RING_BYTES = 131072;
constexpr int LDS_BYTES = 147456;
constexpr int LDSCTL_OFF = LDS_BYTES - 1024, MISC_OFF = LDSCTL_OFF + 320;

#define LDS_WAIT() asm volatile("s_waitcnt lgkmcnt(0)" ::: "memory")
#define VM_WAIT() asm volatile("s_waitcnt vmcnt(0)" ::: "memory")
__device__ __forceinline__ unsigned f2bf(float f) { unsigned u = __builtin_bit_cast(unsigned, f); return (u + 0x7fffu + ((u >> 16) & 1u)) >> 16; }
__device__ __forceinline__ unsigned pk2(float lo, float hi) { return f2bf(lo) | (f2bf(hi) << 16); }
__device__ __forceinline__ float bf2f(unsigned short b) { return __builtin_bit_cast(float, (unsigned)b << 16); }
__device__ __forceinline__ float bflo(unsigned w) { return __builtin_bit_cast(float, w << 16); }
__device__ __forceinline__ float bfhi(unsigned w) { return __builtin_bit_cast(float, w & 0xffff0000u); }
__device__ __forceinline__ unsigned cvtpk(float lo, float hi) { unsigned r; asm volatile("v_cvt_pk_bf16_f32 %0, %1, %2" : "=v"(r) : "v"(lo), "v"(hi)); return r; }
__device__ __forceinline__ float sigmoidf_(float x) { return __builtin_amdgcn_rcpf(1.0f + __builtin_amdgcn_exp2f(-1.4426950408889634f * x)); }
__device__ __forceinline__ float wave_sum(float v) {
#pragma unroll
    for (int o = 1; o < 64; o <<= 1) v += __shfl_xor(v, o);
    return v;
}

#define XB_TMO      128
#define XB_XCNT(j)  (256  + 64 * (j))
#define XB_XSUB(j)  (1280 + 64 * (j))
#define XB_XGEN(j)  (2304 + 64 * (j))
#define XB_TOP      3328
#define XB_TOPGEN   3392
#define XCD_BAR_WORDS 3456
#define XB_SPIN_CAP (1u << 18)
__device__ __forceinline__ unsigned xb_ld(unsigned* p)              { return __hip_atomic_load(p, __ATOMIC_RELAXED, __HIP_MEMORY_SCOPE_AGENT); }
__device__ __forceinline__ unsigned xb_add(unsigned* p, unsigned v) { return __hip_atomic_fetch_add(p, v, __ATOMIC_RELAXED, __HIP_MEMORY_SCOPE_AGENT); }
__device__ __forceinline__ unsigned xb_xcc_id() { return (unsigned)__builtin_amdgcn_s_getreg((3 << 11) | 20) & 0xFu; }
#define XB_SPIN(cond, bar) do { unsigned _sp = 0; while (cond) { __builtin_amdgcn_s_sleep(1); \
    if ((++_sp & 255u) == 0u) { if (xb_ld(&(bar)[XB_TMO])) break; if (_sp > XB_SPIN_CAP) { atomicAdd(&(bar)[XB_TMO], 1u); break; } } } } while (0)
struct XcdBarrier { unsigned* bar; unsigned x; volatile LAS unsigned* st; };
__device__ __forceinline__ XcdBarrier xcd_barrier_post(unsigned* bar, volatile LAS unsigned* st) {
    XcdBarrier b; b.bar = bar; b.x = xb_xcc_id(); b.st = st;
    if (threadIdx.x == 0) (void)xb_add(&bar[XB_XCNT(b.x)], 1u);
    return b;
}
__device__ __forceinline__ void xcd_barrier_complete(unsigned* bar, unsigned x, unsigned& nloc, unsigned& nx) {
    const unsigned G = gridDim.x * gridDim.y * gridDim.z;
    unsigned sum, cnt, mine, sp = 0u;
    for (;;) {
        sum = 0u; cnt = 0u; mine = 0u;
#pragma unroll
        for (unsigned j = 0; j < 16; ++j) { const unsigned c = xb_ld(&bar[XB_XCNT(j)]); sum += c; cnt += (c > 0u) ? 1u : 0u; mine = (j == x) ? c : mine; }
        if (sum == G) break;
        __builtin_amdgcn_s_sleep(1);
        if ((++sp & 255u) == 0u) { if (xb_ld(&bar[XB_TMO])) break; if (sp > XB_SPIN_CAP) { atomicAdd(&bar[XB_TMO], 1u); break; } }
    }
    nloc = mine > 0u ? mine : 1u; nx = cnt > 0u ? cnt : 1u;
}
__device__ __forceinline__ void xcd_barrier(const XcdBarrier& b) {
    asm volatile("s_waitcnt vmcnt(0)" ::: "memory");
    __syncthreads();
    if (threadIdx.x == 0) {
        unsigned* bar = b.bar;
        __builtin_amdgcn_s_waitcnt(0);
        unsigned nloc = b.st[0], nx = b.st[1];
        if (nloc == 0u) { xcd_barrier_complete(bar, b.x, nloc, nx); b.st[0] = nloc; b.st[1] = nx; }
        const unsigned old = xb_add(&bar[XB_XSUB(b.x)], 1u);
        const unsigned gen = old / nloc;
        if (old + 1u == (gen + 1u) * nloc) {
            __builtin_amdgcn_fence(__ATOMIC_RELEASE, "agent");
            asm volatile("s_waitcnt vmcnt(0)" ::: "memory");
            const unsigned og = xb_add(&bar[XB_TOP], 1u);
            const unsigned tg = og / nx;
            if (og + 1u == (tg + 1u) * nx) xb_add(&bar[XB_TOPGEN], 1u);
            else XB_SPIN(xb_ld(&bar[XB_TOPGEN]) == tg, bar);
            __builtin_amdgcn_fence(__ATOMIC_ACQUIRE, "agent");
            xb_add(&bar[XB_XGEN(b.x)], 1u);
            asm volatile("s_waitcnt vmcnt(0)" ::: "memory");
        } else {
            XB_SPIN(xb_ld(&bar[XB_XGEN(b.x)]) == gen, bar);
            __builtin_amdgcn_fence(__ATOMIC_ACQUIRE, "agent");
            asm volatile("s_waitcnt vmcnt(0)" ::: "memory");
        }
    }
    __syncthreads();
}

namespace pg8 {
constexpr int BM = 256, BK = 64, HALF = 128, HTB = HALF * BK * 2, STAGE_BYTES = 8 * HTB, NXCD = 8, WGM = 8;
__host__ __device__ __forceinline__ int lds_byte(int r, int c) { const int st = (r >> 4) * 2 + (c >> 5), rr = r & 15, cc = c & 31, ob = rr * 64 + cc * 2; return st * 1024 + (ob ^ (((ob >> 9) & 1) << 5)); }
__host__ __device__ __forceinline__ void stage_rc(int b, int& R, int& C) { const int st = b / 1024, sb = b % 1024, swz = sb ^ (((sb >> 9) & 1) << 5); R = (st >> 1) * 16 + swz / 64; C = (st & 1) * 32 + (swz % 64) / 2; }
__host__ __device__ __forceinline__ int perm32(int rho) { const int n = rho >> 4, i = rho & 15; return 8 * (i >> 2) + 4 * n + (i & 3); }

struct Unit { int pm, pn, z; };
struct Gemm { const bf16_t* A; const bf16_t* Bt; const bf16_t* A2; const bf16_t* Bt2; int M, N, K; };

struct StaticOrder {
    int nM, nN, nwg, G, c;
    __host__ __device__ void init(int M_, int N_, int G_, int c_) { nM = M_ / BM; nN = N_ / BM; nwg = nM * nN; G = G_; c = c_; }
    __host__ __device__ bool next(int i, Unit& u) const {
        const long L = (long)i * G + c; if (L >= nwg) return false;
        int wgid = (int)L; { const int q = nwg / NXCD, r = nwg % NXCD, xcd = wgid % NXCD, off = wgid / NXCD; wgid = (xcd < r ? xcd * (q + 1) : r * (q + 1) + (xcd - r) * q) + off; }
        const int nig = WGM * nN, gid = wgid / nig, fm = gid * WGM, gsz = (nM - fm) < WGM ? (nM - fm) : WGM;
        u.pm = fm + ((wgid % nig) % gsz); u.pn = (wgid % nig) / gsz; u.z = 0; return true;
    }
    __device__ __forceinline__ void a_ready(const Unit&) const {}
    __device__ __forceinline__ void done(const Unit&) const {}
};
struct DualOrder : StaticOrder {
    __host__ __device__ bool next(int i, Unit& u) const { const bool ok = StaticOrder::next(i >> 1, u); u.z = i & 1; return ok; }
};

template <class Epi, class Sched, bool ALIGN_EPI = true, bool SP2 = true>
__device__ __forceinline__ void gemm_phase(LAS unsigned char* lds, const Gemm g, const Sched& S, const Epi& E) {
    const int tid = threadIdx.x, wid = __builtin_amdgcn_readfirstlane(tid >> 6), lane = tid & 63, wr = wid >> 2, wc = wid & 3, fr = lane & 15, fq = lane >> 4;
    const int K = g.K, nt = K / BK;
    unsigned voffA[2], voffB[2];
#pragma unroll
    for (int i = 0; i < 2; ++i) { int R, C; stage_rc(tid * 16 + i * 8192, R, C); const int Rb = Epi::PERM ? ((R & ~31) + perm32(R & 31)) : R;
        voffA[i] = (unsigned)(R * K + C) * 2u; voffB[i] = (unsigned)(Rb * K + C) * 2u; }
    const size_t kstep = (size_t)(BK * 2);
    const size_t hstep = (size_t)HALF * K * 2;
    const size_t tstep = 2 * hstep;
    const unsigned ldsw = (unsigned)wid * 1024u;
    const int aoff = lds_byte(wr * 64 + fr, fq * 8), boff = lds_byte(wc * 32 + fr, fq * 8);
#define PG8_SA(b, h) (((b) * 2 + (h)) * HTB)
#define PG8_SB(b, h) ((4 + (b) * 2 + (h)) * HTB)
#define PG8_STAGE(bufoff, gbase, voff) do { _Pragma("unroll") for (int _i = 0; _i < 2; ++_i) \
        __builtin_amdgcn_global_load_lds((const unsigned*)((const char*)(gbase) + (voff)[_i]), (LAS unsigned*)(lds + (bufoff) + ldsw + _i * 8192), 16, 0, 0); } while (0)
#define PG8_LDA(dst, b, h) do { _Pragma("unroll") for (int m = 0; m < 4; ++m) _Pragma("unroll") for (int k = 0; k < 2; ++k) dst[m][k] = *(const LAS bf16x8*)(lds + PG8_SA(b, h) + aoff + m * 2048 + k * 1024); } while (0)
#define PG8_LDB(dst, b, h) do { _Pragma("unroll") for (int n = 0; n < 2; ++n) _Pragma("unroll") for (int k = 0; k < 2; ++k) dst[n][k] = *(const LAS bf16x8*)(lds + PG8_SB(b, h) + boff + n * 2048 + k * 1024); } while (0)
#define PG8_MMA(ai, bj, At, Bt) do { __builtin_amdgcn_s_setprio(1); _Pragma("unroll") for (int m = 0; m < 4; ++m) _Pragma("unroll") for (int n = 0; n < 2; ++n) _Pragma("unroll") for (int k = 0; k < 2; ++k) \
        acc[ai][bj][m][n] = __builtin_amdgcn_mfma_f32_16x16x32_bf16(Bt[n][k], At[m][k], acc[ai][bj][m][n], 0, 0, 0); __builtin_amdgcn_s_setprio(0); } while (0)
#define PG8_WAIT_V(n) asm volatile("s_waitcnt vmcnt(" #n ")" ::: "memory")
#define PG8_WAIT_L(n) asm volatile("s_waitcnt lgkmcnt(" #n ")" ::: "memory")
#define PG8_BAR __builtin_amdgcn_s_barrier()
#define PG8_SCHED __builtin_amdgcn_sched_barrier(0)
#define PG8_ABASE(u) ((const char*)((u).z ? g.A2 : g.A) + (size_t)(u).pm * tstep)
#define PG8_BBASE(u) ((const char*)((u).z ? g.Bt2 : g.Bt) + (size_t)(u).pn * tstep)
    Unit cur, nxt; int ui = 0;
    if (!S.next(0, cur)) return;
    f32x4 acc[2][2][4][2];
#pragma unroll
    for (int a = 0; a < 2; ++a)
#pragma unroll
        for (int b = 0; b < 2; ++b)
#pragma unroll
            for (int m = 0; m < 4; ++m)
#pragma unroll
                for (int n = 0; n < 2; ++n) acc[a][b][m][n] = (f32x4){0.f, 0.f, 0.f, 0.f};
    bf16x8 At[4][2], B0[2][2], B1[2][2];
    const char* cA = PG8_ABASE(cur); const char* cB = PG8_BBASE(cur);
    S.a_ready(cur);
    if constexpr (SP2) {
        PG8_STAGE(PG8_SB(0, 0), cB, voffB); PG8_STAGE(PG8_SB(0, 1), cB + hstep, voffB); PG8_STAGE(PG8_SA(0, 0), cA, voffA); PG8_STAGE(PG8_SA(0, 1), cA + hstep, voffA);
        if (wr == 1) PG8_BAR;
        PG8_WAIT_V(2); PG8_BAR;
        PG8_STAGE(PG8_SB(1, 0), cB + kstep, voffB); PG8_STAGE(PG8_SA(1, 0), cA + kstep, voffA); PG8_STAGE(PG8_SB(1, 1), cB + hstep + kstep, voffB);
        PG8_WAIT_V(6); PG8_BAR;
    } else {
        PG8_STAGE(PG8_SB(0, 0), cB, voffB); PG8_STAGE(PG8_SA(0, 0), cA, voffA); PG8_STAGE(PG8_SB(0, 1), cB + hstep, voffB); PG8_STAGE(PG8_SA(0, 1), cA + hstep, voffA);
        if (wr == 1) PG8_BAR;
        PG8_WAIT_V(4); PG8_BAR;
        PG8_STAGE(PG8_SB(1, 0), cB + kstep, voffB); PG8_STAGE(PG8_SA(1, 0), cA + kstep, voffA); PG8_STAGE(PG8_SB(1, 1), cB + hstep + kstep, voffB);
        PG8_WAIT_V(6); PG8_BAR;
    }
    for (;;) {
        const bool has_next = S.next(ui + 1, nxt);
        const char* nA = has_next ? PG8_ABASE(nxt) : cA; const char* nB = has_next ? PG8_BBASE(nxt) : cB;
        for (int t = 0; t < nt; t += 2) {
            const bool last = (t == nt - 2);
            const char* a1 = cA + (size_t)(t + 1) * kstep;
            const char* a2 = last ? nA : cA + (size_t)(t + 2) * kstep; const char* b2 = last ? nB : cB + (size_t)(t + 2) * kstep;
            const char* a3 = a2 + kstep; const char* b3 = b2 + kstep;
            if (last && has_next) S.a_ready(nxt);
            if constexpr (SP2) {
            PG8_LDB(B0, 0, 0); PG8_LDB(B1, 0, 1); PG8_SCHED; PG8_LDA(At, 0, 0); PG8_STAGE(PG8_SA(1, 1), a1 + hstep, voffA);
            PG8_WAIT_V(8); PG8_WAIT_L(0); PG8_BAR; PG8_MMA(0, 0, At, B0); PG8_MMA(0, 1, At, B1); PG8_BAR; PG8_SCHED;
            PG8_LDA(At, 0, 1); PG8_STAGE(PG8_SB(0, 0), b2, voffB); PG8_STAGE(PG8_SB(0, 1), b2 + hstep, voffB); PG8_STAGE(PG8_SA(0, 0), a2, voffA);
            PG8_WAIT_V(8); PG8_WAIT_L(0); PG8_BAR; PG8_MMA(1, 0, At, B0); PG8_MMA(1, 1, At, B1); PG8_BAR; PG8_SCHED;
            PG8_LDB(B0, 1, 0); PG8_LDB(B1, 1, 1); PG8_SCHED; PG8_LDA(At, 1, 0); PG8_STAGE(PG8_SA(0, 1), a2 + hstep, voffA);
            PG8_WAIT_V(8); PG8_WAIT_L(0); PG8_BAR; PG8_MMA(0, 0, At, B0); PG8_MMA(0, 1, At, B1); PG8_BAR; PG8_SCHED;
            PG8_LDA(At, 1, 1); PG8_STAGE(PG8_SB(1, 0), b3, voffB); PG8_STAGE(PG8_SB(1, 1), b3 + hstep, voffB); PG8_STAGE(PG8_SA(1, 0), a3, voffA);
            PG8_WAIT_V(8); PG8_WAIT_L(0); PG8_BAR; PG8_MMA(1, 0, At, B0); PG8_MMA(1, 1, At, B1); PG8_BAR; PG8_SCHED;
            } else {
            PG8_LDB(B0, 0, 0); PG8_SCHED; PG8_LDA(At, 0, 0); PG8_STAGE(PG8_SA(1, 1), a1 + hstep, voffA);
            PG8_WAIT_L(8); PG8_BAR; PG8_WAIT_L(0); PG8_MMA(0, 0, At, B0); PG8_BAR; PG8_SCHED;
            PG8_LDB(B1, 0, 1); PG8_STAGE(PG8_SB(0, 0), b2, voffB);
            PG8_BAR; PG8_WAIT_L(0); PG8_MMA(0, 1, At, B1); PG8_BAR;
            PG8_LDA(At, 0, 1); PG8_STAGE(PG8_SA(0, 0), a2, voffA);
            PG8_BAR; PG8_WAIT_L(0); PG8_MMA(1, 0, At, B0); PG8_BAR; PG8_SCHED;
            PG8_STAGE(PG8_SB(0, 1), b2 + hstep, voffB);
            PG8_WAIT_V(6); PG8_BAR; PG8_MMA(1, 1, At, B1); PG8_BAR;
            PG8_LDB(B0, 1, 0); PG8_SCHED; PG8_LDA(At, 1, 0); PG8_STAGE(PG8_SA(0, 1), a2 + hstep, voffA);
            PG8_WAIT_L(8); PG8_BAR; PG8_WAIT_L(0); PG8_MMA(0, 0, At, B0); PG8_BAR; PG8_SCHED;
            PG8_LDB(B1, 1, 1); PG8_STAGE(PG8_SB(1, 0), b3, voffB);
            PG8_BAR; PG8_WAIT_L(0); PG8_MMA(0, 1, At, B1); PG8_BAR;
            PG8_LDA(At, 1, 1); PG8_STAGE(PG8_SA(1, 0), a3, voffA);
            PG8_BAR; PG8_WAIT_L(0); PG8_MMA(1, 0, At, B0); PG8_BAR; PG8_SCHED;
            PG8_STAGE(PG8_SB(1, 1), b3 + hstep, voffB);
            PG8_WAIT_V(6); PG8_BAR; PG8_MMA(1, 1, At, B1); PG8_BAR;
            }
        }
        if constexpr (ALIGN_EPI) { if (wr == 0) PG8_BAR; }
        E(acc, cur, wr, wc, fr, fq);
        if (!has_next) break;
#pragma unroll
        for (int a = 0; a < 2; ++a)
#pragma unroll
            for (int b = 0; b < 2; ++b)
#pragma unroll
                for (int m = 0; m < 4; ++m)
#pragma unroll
                    for (int n = 0; n < 2; ++n) acc[a][b][m][n] = (f32x4){0.f, 0.f, 0.f, 0.f};
        cur = nxt; cA = nA; cB = nB; ++ui;
        if constexpr (ALIGN_EPI) { if (wr == 1) PG8_BAR; }
    }
    PG8_WAIT_V(0);
    if constexpr (!ALIGN_EPI) { if (wr == 0) PG8_BAR; }
    PG8_BAR;
#undef PG8_SA
#undef PG8_SB
#undef PG8_STAGE
#undef PG8_LDA
#undef PG8_LDB
#undef PG8_MMA
#undef PG8_WAIT_V
#undef PG8_WAIT_L
#undef PG8_BAR
#undef PG8_SCHED
#undef PG8_ABASE
#undef PG8_BBASE
}

#define EPI_ROWS_BEGIN _Pragma("unroll") for (int ai = 0; ai < 2; ++ai) _Pragma("unroll") for (int m = 0; m < 4; ++m) { const size_t row = (size_t)(u.pm * BM + ai * HALF + wr * 64 + m * 16 + fr);
#define EPI_ROWS_END }
__device__ __forceinline__ u32x4 pack8f(f32x4 a, f32x4 b) { u32x4 w; w.x = cvtpk(a[0], a[1]); w.y = cvtpk(a[2], a[3]); w.z = cvtpk(b[0], b[1]); w.w = cvtpk(b[2], b[3]); return w; }
__device__ __forceinline__ void unpack8f(u32x4 w, f32x4& a, f32x4& b) { a = (f32x4){bflo(w.x), bfhi(w.x), bflo(w.y), bfhi(w.y)}; b = (f32x4){bflo(w.z), bfhi(w.z), bflo(w.w), bfhi(w.w)}; }
__device__ __forceinline__ f32x4 sig4(f32x4 v) { return (f32x4){sigmoidf_(v[0]), sigmoidf_(v[1]), sigmoidf_(v[2]), sigmoidf_(v[3])}; }

struct EpiP1 {
    static constexpr bool PERM = true;
    bf16_t *cq, *kva, *qkvb, *gates; float* misc; const float* gqb; const float* gkb; LAS float* xch;
    __device__ __forceinline__ void operator()(const f32x4 (&acc)[2][2][4][2], const Unit& u, int wr, int wc, int fr, int fq) const {
        const int pn = u.pn, cl = wc * 32 + 8 * fq;
        if (pn >= 7 && pn < 23) {
            const int t = (pn - 7) >> 3;
            const float* gp = (t ? gkb : gqb) + cl;
            const f32x4 g0 = *(const f32x4*)gp, g1 = *(const f32x4*)(gp + 4);
#pragma unroll
            for (int ai = 0; ai < 2; ++ai)
#pragma unroll
                for (int m = 0; m < 4; ++m)
#pragma unroll
                    for (int bj = 0; bj < 2; ++bj) { const f32x4 a0 = acc[ai][bj][m][0], a1 = acc[ai][bj][m][1];
                        float v = (a0[0] * a0[0] + a0[1] * a0[1]) + (a0[2] * a0[2] + a0[3] * a0[3]) + (a1[0] * a1[0] + a1[1] * a1[1]) + (a1[2] * a1[2] + a1[3] * a1[3]);
                        v += __shfl_xor(v, 16); v += __shfl_xor(v, 32);
                        if (fq == 0) xch[((((wr * 2 + ai) * 4 + m) * 16 + fr) * 2 + bj) * 4 + wc] = v; }
            LDS_WAIT(); __builtin_amdgcn_s_barrier();
            bf16_t* base = qkvb + (size_t)t * ((size_t)M * 2048) + ((pn - 7) & 7) * 256 + cl;
            EPI_ROWS_BEGIN
                bf16_t* rowp = base + row * 2048;
#pragma unroll
                for (int bj = 0; bj < 2; ++bj) { const f32x4 p4 = *(const LAS f32x4*)(xch + ((((wr * 2 + ai) * 4 + m) * 16 + fr) * 2 + bj) * 4);
                    const float rstd = 1.0f / sqrtf(((p4[0] + p4[1]) + (p4[2] + p4[3])) * (1.f / 128.f) + EPS);
                    *(u32x4*)(rowp + bj * HALF) = pack8f(acc[ai][bj][m][0] * rstd * g0, acc[ai][bj][m][1] * rstd * g1); }
            EPI_ROWS_END
            return;
        }
        if (pn == 6) {
            EPI_ROWS_BEGIN
                float* rowp = misc + row * 256 + cl;
#pragma unroll
                for (int bj = 0; bj < 2; ++bj) { *(f32x4*)(rowp + bj * HALF) = acc[ai][bj][m][0]; *(f32x4*)(rowp + bj * HALF + 4) = acc[ai][bj][m][1]; }
            EPI_ROWS_END
            return;
        }
        bf16_t* base; int ldc;
        if (pn >= 31) { base = gates + (pn - 31) * 256; ldc = 8192; }
        else if (pn < 4) { base = cq + pn * 256; ldc = 1024; }
        else if (pn < 6) { base = kva + (pn - 4) * 256; ldc = 512; }
        else { const int t = (pn - 7) >> 3; base = qkvb + (size_t)t * ((size_t)M * 2048) + ((pn - 7) & 7) * 256; ldc = 2048; }
        base += cl;
        EPI_ROWS_BEGIN
            bf16_t* rowp = base + row * ldc;
#pragma unroll
            for (int bj = 0; bj < 2; ++bj) *(u32x4*)(rowp + bj * HALF) = pack8f(acc[ai][bj][m][0], acc[ai][bj][m][1]);
        EPI_ROWS_END
    }
};
struct EpiBf16 {
    static constexpr bool PERM = true;
    bf16_t* O; int ldc; int split_cols; size_t split_stride;
    __device__ __forceinline__ void operator()(const f32x4 (&acc)[2][2][4][2], const Unit& u, int wr, int wc, int fr, int fq) const {
        int colt = u.pn * BM; bf16_t* base = O;
        if (split_cols) { const int t = colt / split_cols; base += (size_t)t * split_stride; colt -= t * split_cols; }
        base += colt + wc * 32 + 8 * fq;
        EPI_ROWS_BEGIN
            bf16_t* rowp = base + row * ldc;
#pragma unroll
            for (int bj = 0; bj < 2; ++bj) *(u32x4*)(rowp + bj * HALF) = pack8f(acc[ai][bj][m][0], acc[ai][bj][m][1]);
        EPI_ROWS_END
    }
};
struct EpiMerge {
    static constexpr bool PERM = true;
    const bf16_t* gates; bf16_t* pscr; bf16_t* merged;
    __device__ __forceinline__ void operator()(const f32x4 (&acc)[2][2][4][2], const Unit& u, int wr, int wc, int fr, int fq) const {
        const int col = u.pn * BM + wc * 32 + 8 * fq;
#pragma unroll
        for (int ai = 0; ai < 2; ++ai) {
            const size_t row0 = (size_t)(u.pm * BM + ai * HALF + wr * 64 + fr);
            u32x4 gq[4][2], pq[4][2];
#pragma unroll
            for (int m = 0; m < 4; ++m)
#pragma unroll
                for (int bj = 0; bj < 2; ++bj) { const size_t row = row0 + m * 16;
                    gq[m][bj] = __builtin_nontemporal_load((const u32x4*)(gates + row * 8192 + (size_t)u.z * 4096 + col + bj * HALF));
                    if (u.z != 0) pq[m][bj] = *(const u32x4*)(pscr + row * 4096 + col + bj * HALF); else pq[m][bj] = (u32x4){0u, 0u, 0u, 0u}; }
            asm volatile("" ::: "memory");
#pragma unroll
            for (int m = 0; m < 4; ++m)
#pragma unroll
                for (int bj = 0; bj < 2; ++bj) { const size_t o = (row0 + m * 16) * 4096 + col + bj * HALF;
                    f32x4 g0, g1; unpack8f(gq[m][bj], g0, g1);
                    f32x4 v0 = acc[ai][bj][m][0] * sig4(g0), v1 = acc[ai][bj][m][1] * sig4(g1);
                    if (u.z == 0) *(u32x4*)(pscr + o) = pack8f(v0, v1);
                    else { f32x4 p0, p1; unpack8f(pq[m][bj], p0, p1); *(u32x4*)(merged + o) = pack8f(v0 + p0, v1 + p1); } }
            asm volatile("" ::: "memory");
        }
    }
};
struct EpiResid {
    static constexpr bool PERM = true;
    const float* base; float* out;
    __device__ __forceinline__ void operator()(const f32x4 (&acc)[2][2][4][2], const Unit& u, int wr, int wc, int fr, int fq) const {
        const int col = u.pn * BM + wc * 32 + 8 * fq;
        EPI_ROWS_BEGIN
#pragma unroll
            for (int bj = 0; bj < 2; ++bj) { const size_t o = row * 4096 + col + bj * HALF;
                const f32x4 b0 = *(const f32x4*)(base + o), b1 = *(const f32x4*)(base + o + 4);
                *(f32x4*)(out + o) = b0 + acc[ai][bj][m][0]; *(f32x4*)(out + o + 4) = b1 + acc[ai][bj][m][1]; }
            if (m & 1) asm volatile("" ::: "memory");
        EPI_ROWS_END
    }
};
template <bool BASE_BF16>
struct EpiResidNorm {
    static constexpr bool PERM = true;
    const void* base; bf16_t* xb; float* ss;
    __device__ __forceinline__ void operator()(const f32x4 (&acc)[2][2][4][2], const Unit& u, int wr, int wc, int fr, int fq) const {
        const int col = u.pn * BM + wc * 32 + 8 * fq;
#pragma unroll
        for (int ai = 0; ai < 2; ++ai) {
            const size_t row0 = (size_t)(u.pm * BM + ai * HALF + wr * 64 + fr);
            f32x4 bq[4][2][2];
            if (BASE_BF16) {
                u32x4 raw[4][2];
#pragma unroll
                for (int m = 0; m < 4; ++m)
#pragma unroll
                    for (int bj = 0; bj < 2; ++bj) raw[m][bj] = *(const u32x4*)((const bf16_t*)base + (row0 + m * 16) * 4096 + col + bj * HALF);
                asm volatile("" ::: "memory");
#pragma unroll
                for (int m = 0; m < 4; ++m)
#pragma unroll
                    for (int bj = 0; bj < 2; ++bj) unpack8f(raw[m][bj], bq[m][bj][0], bq[m][bj][1]);
            } else {
#pragma unroll
                for (int m = 0; m < 4; ++m)
#pragma unroll
                    for (int bj = 0; bj < 2; ++bj) { const float* p = (const float*)base + (row0 + m * 16) * 4096 + col + bj * HALF; bq[m][bj][0] = __builtin_nontemporal_load((const f32x4*)p); bq[m][bj][1] = __builtin_nontemporal_load((const f32x4*)(p + 4)); }
                asm volatile("" ::: "memory");
            }
#pragma unroll
            for (int m = 0; m < 4; ++m) { const size_t row = row0 + m * 16;
                float sq = 0.f;
#pragma unroll
                for (int bj = 0; bj < 2; ++bj) { const size_t o = row * 4096 + col + bj * HALF;
                    const f32x4 v0 = bq[m][bj][0] + acc[ai][bj][m][0], v1 = bq[m][bj][1] + acc[ai][bj][m][1];
                    *(u32x4*)(xb + o) = pack8f(v0, v1);
                    sq += (v0[0] * v0[0] + v0[1] * v0[1]) + (v0[2] * v0[2] + v0[3] * v0[3]) + (v1[0] * v1[0] + v1[1] * v1[1]) + (v1[2] * v1[2] + v1[3] * v1[3]); }
                sq += __shfl_xor(sq, 16); sq += __shfl_xor(sq, 32);
                if (fq == 0) atomicAdd(ss + row, sq); }
            asm volatile("" ::: "memory");
        }
    }
};
struct EpiSwiGLU {
    static constexpr bool PERM = true;
    bf16_t* act; const float* ss;
    __device__ __forceinline__ void operator()(const f32x4 (&acc)[2][2][4][2], const Unit& u, int wr, int wc, int fr, int fq) const {
        bf16_t* base = act + u.pn * HALF + wc * 32 + 8 * fq;
        float sq[2][4];
#pragma unroll
        for (int ai = 0; ai < 2; ++ai)
#pragma unroll
            for (int m = 0; m < 4; ++m) sq[ai][m] = ss[u.pm * BM + ai * HALF + wr * 64 + m * 16 + fr];
        asm volatile("" ::: "memory");
        EPI_ROWS_BEGIN
            const float r = 1.0f / sqrtf(sq[ai][m] * (1.f / 4096.f) + EPS);
            const f32x4 g0 = acc[ai][0][m][0] * r, g1 = acc[ai][0][m][1] * r;
            *(u32x4*)(base + row * DFF) = pack8f(g0 * sig4(g0) * (acc[ai][1][m][0] * r), g1 * sig4(g1) * (acc[ai][1][m][1] * r));
        EPI_ROWS_END
    }
};
struct EpiPle {
    static constexpr bool PERM = true;
    const bf16_t* E; const bf16_t* x2; float* out; const float* ss;
    __device__ __forceinline__ void operator()(const f32x4 (&acc)[2][2][4][2], const Unit& u, int wr, int wc, int fr, int fq) const {
        const int col = u.pn * BM + wc * 32 + 8 * fq;
#pragma unroll
        for (int ai = 0; ai < 2; ++ai) {
            const size_t row0 = (size_t)(u.pm * BM + ai * HALF + wr * 64 + fr);
            u32x4 eq[4][2], xq[4][2]; float sq[4];
#pragma unroll
            for (int m = 0; m < 4; ++m) { sq[m] = ss[row0 + m * 16];
#pragma unroll
                for (int bj = 0; bj < 2; ++bj) { const size_t o = (row0 + m * 16) * 4096 + col + bj * HALF;
                    eq[m][bj] = __builtin_nontemporal_load((const u32x4*)(E + o)); xq[m][bj] = *(const u32x4*)(x2 + o); } }
            asm volatile("" ::: "memory");
#pragma unroll
            for (int m = 0; m < 4; ++m) {
                const float r = 1.0f / sqrtf(sq[m] * (1.f / 4096.f) + EPS);
#pragma unroll
                for (int bj = 0; bj < 2; ++bj) { const size_t o = (row0 + m * 16) * 4096 + col + bj * HALF;
                    f32x4 e0, e1, b0, b1; unpack8f(eq[m][bj], e0, e1); unpack8f(xq[m][bj], b0, b1);
                    *(f32x4*)(out + o) = b0 + sig4(acc[ai][bj][m][0] * r) * e0; *(f32x4*)(out + o + 4) = b1 + sig4(acc[ai][bj][m][1] * r) * e1; } }
            asm volatile("" ::: "memory");
        }
    }
};
#undef EPI_ROWS_BEGIN
#undef EPI_ROWS_END
}

namespace fa {
constexpr int NW = 8, QBLK = 32, KVBLK = 64, QB = NW * QBLK, D = 128;
constexpr int SHM_V = KVBLK * D * 2, SHM_K = KVBLK * D * 2;
constexpr int LDS_USE = 2 * SHM_V + 2 * SHM_K + NW * 64 * 4;
constexpr float THR = 8.f;
#define KSWZ(row, colB) ((row) * 256 + ((colB) ^ (((row) & 7) << 4)))
#ifdef FA_HEAVY
#define SBAR() do { asm volatile("s_waitcnt vmcnt(0) lgkmcnt(0)" ::: "memory"); __syncthreads(); } while (0)
#else
#define SBAR() __builtin_amdgcn_sched_barrier(0)
#endif
__device__ __forceinline__ int v_st(int k, int c) { const int kk = (k & ~0xC) | ((k & 4) << 1) | ((k & 8) >> 1); return ((kk >> 3) * 4 + (c >> 5)) * 512 + ((kk & 7) * 32 + (c & 31)) * 2; }
__device__ __forceinline__ int v_rd_base(int lane) { return ((lane & 3) << 3) | (((lane >> 2) & 3) << 6) | (((lane >> 4) & 1) << 5) | (((lane >> 5) & 1) << 8); }
constexpr int v_rd_off(int d0, int ks, int half) { return d0 * 512 + ks * 4096 + half * 2048; }
__device__ __forceinline__ int crow(int r, int hi) { return (r & 3) + 8 * (r >> 2) + 4 * hi; }

__device__ __forceinline__ void mask_causal(f32x16& p0, f32x16& p1, int dq) {
    const float NEG = -__builtin_inff();
#pragma unroll
    for (int r = 0; r < 16; ++r) {
        const int c = (r & 3) + 8 * (r >> 2);
        if (dq - c < 0) p0[r] = NEG;
        if (dq - c - 32 < 0) p1[r] = NEG;
    }
}
__device__ __forceinline__ void mask_bits(f32x16& p0, f32x16& p1, unsigned long long mk, int hi) {
    const float NEG = -__builtin_inff();
    const unsigned lo = (unsigned)mk >> (4 * hi), hh = (unsigned)(mk >> 32) >> (4 * hi);
#pragma unroll
    for (int r = 0; r < 16; ++r) {
        const int c = (r & 3) + 8 * (r >> 2);
        if (!(lo & (1u << c))) p0[r] = NEG;
        if (!(hh & (1u << c))) p1[r] = NEG;
    }
}
__device__ __forceinline__ void partialSM(f32x16& p0, f32x16& p1, float& m_reg, float& mn, float& alpha) {
    float pmax = p0[0];
#pragma unroll
    for (int r = 1; r < 16; ++r) pmax = fmaxf(pmax, p0[r]);
#pragma unroll
    for (int r = 0; r < 16; ++r) pmax = fmaxf(pmax, p1[r]);
    { auto rr = __builtin_amdgcn_permlane32_swap(__float_as_uint(pmax), __float_as_uint(pmax), false, false);
      pmax = fmaxf(__uint_as_float(rr[0]), __uint_as_float(rr[1])); }
    constexpr float C2 = 1.4426950408889634f * SM_SCALE;
    if (__builtin_expect(__all((pmax - m_reg) * SM_SCALE <= THR), 1)) { mn = m_reg; alpha = 1.f; }
    else { mn = fmaxf(m_reg, pmax); alpha = __builtin_amdgcn_exp2f((m_reg - mn) * C2); m_reg = mn; }
    const float mnL = -mn * C2;
#pragma unroll
    for (int r = 0; r < 16; ++r) p0[r] = fmaf(p0[r], C2, mnL);
#pragma unroll
    for (int r = 0; r < 16; ++r) p1[r] = fmaf(p1[r], C2, mnL);
#pragma unroll
    for (int r = 0; r < 16; ++r) p0[r] = __builtin_amdgcn_exp2f(p0[r]);
}
__device__ __forceinline__ void finishSM(f32x16& p0, f32x16& p1, float alpha, float& l_reg, bf16x8& pa0, bf16x8& pa1, bf16x8& pa2, bf16x8& pa3) {
#pragma unroll
    for (int r = 0; r < 16; ++r) p1[r] = __builtin_amdgcn_exp2f(p1[r]);
    float ps = 0;
#pragma unroll
    for (int r = 0; r < 16; ++r) ps += p0[r];
#pragma unroll
    for (int r = 0; r < 16; ++r) ps += p1[r];
    { auto rr = __builtin_amdgcn_permlane32_swap(__float_as_uint(ps), __float_as_uint(ps), false, false);
      ps = __uint_as_float(rr[0]) + __uint_as_float(rr[1]); }
    l_reg = l_reg * alpha + ps;
#define PK4(P, B_, OUT) do { unsigned a0 = cvtpk(P[B_+0], P[B_+1]), a1 = cvtpk(P[B_+2], P[B_+3]);                          \
        unsigned b0 = cvtpk(P[B_+4], P[B_+5]), b1 = cvtpk(P[B_+6], P[B_+7]);                                             \
        auto r0 = __builtin_amdgcn_permlane32_swap(a0, b0, false, false); auto r1 = __builtin_amdgcn_permlane32_swap(a1, b1, false, false); \
        u32x4 w = {r0[0], r1[0], r0[1], r1[1]}; OUT = *reinterpret_cast<bf16x8*>(&w); } while (0)
    PK4(p0, 0, pa0); PK4(p0, 8, pa1); PK4(p1, 0, pa2); PK4(p1, 8, pa3);
#undef PK4
}
__device__ __forceinline__ bf16x8 bias_frag(float x, int hi) {
    const unsigned b1 = f2bf(x); const float r1 = x - __uint_as_float(b1 << 16);
    const unsigned b2 = f2bf(r1); const float r2 = r1 - __uint_as_float(b2 << 16);
    const unsigned b3 = f2bf(r2);
    u32x4 w = {hi ? 0u : (b1 | (b2 << 16)), hi ? 0u : b3, 0u, 0u};
    return *reinterpret_cast<bf16x8*>(&w);
}
template <int KB, int MODE>
__device__ __forceinline__ void qkt(f32x16& p0, f32x16& p1, const char* K_lds, int r32, int hi, const bf16x8* qr, float bz0, float bz1) {
    p0 = f32x16{}; p1 = f32x16{};
    if (MODE == 0) {
        unsigned hm = (unsigned)hi - 1u; asm volatile("" : "+v"(hm));
        u32x4 ow = {hm & 0x3f803f80u, hm & 0x00003f80u, 0u, 0u};
        const bf16x8 ones = *reinterpret_cast<bf16x8*>(&ow);
        p0 = __builtin_amdgcn_mfma_f32_32x32x16_bf16(bias_frag(bz0, hi), ones, p0, 0, 0, 0);
        p1 = __builtin_amdgcn_mfma_f32_32x32x16_bf16(bias_frag(bz1, hi), ones, p1, 0, 0, 0);
    }
    const char* kb[4];
#pragma unroll
    for (int dd = 0; dd < 4; ++dd) kb[dd] = K_lds + KB * SHM_K + KSWZ(r32, (dd * 16 + hi * 8) * 2);
#pragma unroll
    for (int d0 = 0; d0 < 8; ++d0) { const char* a = kb[d0 & 3] + (d0 >> 2) * 128;
        bf16x8 b0 = *reinterpret_cast<const bf16x8*>(a);
        bf16x8 b1 = *reinterpret_cast<const bf16x8*>(a + 32 * 256);
        p0 = __builtin_amdgcn_mfma_f32_32x32x16_bf16(b0, qr[d0], p0, 0, 0, 0);
        p1 = __builtin_amdgcn_mfma_f32_32x32x16_bf16(b1, qr[d0], p1, 0, 0, 0); }
}
template <int VB>
__device__ __forceinline__ void pv_tile(f32x16* o, int vb0, bf16x8 pa0, bf16x8 pa1, bf16x8 pa2, bf16x8 pa3) {
#define TRRD(dst, off) asm volatile("ds_read_b64_tr_b16 %0, %1 offset:%2" : "=&v"(dst) : "v"(vb0), "i"(off) : "memory")
#define PV_D0(d0) do { s16x4 l0, l1, l2, l3, h0, h1, h2, h3; constexpr int b_ = VB * SHM_V + v_rd_off(d0, 0, 0); \
        TRRD(l0, b_); TRRD(h0, b_ + 2048); TRRD(l1, b_ + 4096); TRRD(h1, b_ + 6144); TRRD(l2, b_ + 8192); TRRD(h2, b_ + 10240); TRRD(l3, b_ + 12288); TRRD(h3, b_ + 14336); \
        asm volatile("s_waitcnt lgkmcnt(0)" ::: "memory"); SBAR();   \
        o[d0] = __builtin_amdgcn_mfma_f32_32x32x16_bf16(pa0, (bf16x8){l0[0], l0[1], l0[2], l0[3], h0[0], h0[1], h0[2], h0[3]}, o[d0], 0, 0, 0);   \
        o[d0] = __builtin_amdgcn_mfma_f32_32x32x16_bf16(pa1, (bf16x8){l1[0], l1[1], l1[2], l1[3], h1[0], h1[1], h1[2], h1[3]}, o[d0], 0, 0, 0);   \
        o[d0] = __builtin_amdgcn_mfma_f32_32x32x16_bf16(pa2, (bf16x8){l2[0], l2[1], l2[2], l2[3], h2[0], h2[1], h2[2], h2[3]}, o[d0], 0, 0, 0);   \
        o[d0] = __builtin_amdgcn_mfma_f32_32x32x16_bf16(pa3, (bf16x8){l3[0], l3[1], l3[2], l3[3], h3[0], h3[1], h3[2], h3[3]}, o[d0], 0, 0, 0); } while (0)
    PV_D0(0); PV_D0(1); PV_D0(2); PV_D0(3);
#undef PV_D0
#undef TRRD
}
struct Ref { const bf16_t* Q; const bf16_t* K; const bf16_t* V; bf16_t* O; const float* bias; const unsigned long long* msk; int P0; int NT; };
struct Seam { bf16x8 qr[8]; bf16x8 st_v0, st_v1, st_k0, st_k1; };
template <int MODE> __device__ __forceinline__ size_t qrow_off(int R) { return MODE == 0 ? (size_t)R * 2048 : (size_t)(R >> 3) * 2048 + (size_t)(R & 7) * 128; }
#define ROW(p, k0, rr) ((p) + (size_t)((k0) + (rr)) * PKV + sc)
#define VMW() asm volatile("s_waitcnt vmcnt(0)" ::: "memory")
#define VMWN(n) asm volatile("s_waitcnt vmcnt(%0)" :: "i"(n) : "memory")
#define LD8(p) (*reinterpret_cast<const bf16x8*>(p))
#define SLOAD_H(Kp, Vp, k0) do { S.st_v0 = LD8(ROW(Vp, k0, sr)); S.st_v1 = LD8(ROW(Vp, k0, 32 + sr));              \
                         S.st_k0 = LD8(ROW(Kp, k0, sr)); S.st_k1 = LD8(ROW(Kp, k0, 32 + sr)); } while (0)
#define SWRITE_HK(bf) do { *(bf16x8*)(K_lds + (bf) * SHM_K + kws) = S.st_k0; *(bf16x8*)(K_lds + (bf) * SHM_K + kws + 32 * 256) = S.st_k1; } while (0)
#define SWRITE_HV(bf) do { *(bf16x8*)(V_lds + (bf) * SHM_V + vst0) = S.st_v0; *(bf16x8*)(V_lds + (bf) * SHM_V + vst1) = S.st_v1; } while (0)
#define SWRITE_H(bf) do { SWRITE_HV(bf); SWRITE_HK(bf); } while (0)
template <int MODE>
__device__ __forceinline__ void prime(const Ref& cur, char* lds, Seam& S) {
    constexpr int PKV = MODE == 0 ? 2048 : 512;
    const int tid = threadIdx.x, wid = __builtin_amdgcn_readfirstlane(tid >> 6), lane = tid & 63, r32 = lane & 31, hi = lane >> 5;
    const int sr = tid >> 4, sc = (tid & 15) * 8, kws = KSWZ(sr, sc * 2); char* K_lds = lds + 2 * SHM_V;
    const bf16_t* qp = cur.Q + qrow_off<MODE>(wid * QBLK + r32) + hi * 8;
#pragma unroll
    for (int d0 = 0; d0 < 8; ++d0) S.qr[d0] = LD8(qp + d0 * 16);
    SLOAD_H(cur.K, cur.V, 0); VMW(); SWRITE_HK(0);
    __syncthreads();
}
template <int MODE>
__device__ __forceinline__ void block(const Ref& cur, const Ref& nxt, char* lds, Seam& S) {
    constexpr int PKV = MODE == 0 ? 2048 : 512;
    const int tid = threadIdx.x, wid = __builtin_amdgcn_readfirstlane(tid >> 6), lane = tid & 63, r32 = lane & 31, hi = lane >> 5;
    const int NT = cur.NT;
    const int qlo = cur.P0 + wid * QBLK, qm = qlo + r32 - 4 * hi;
    char* V_lds = lds; char* K_lds = lds + 2 * SHM_V;
    float* ws = (float*)(lds + 2 * SHM_V + 2 * SHM_K) + wid * 64; float* li_l = ws, * al_l = ws + 32;
    float m_reg = -1e30f, l_reg = 0; f32x16 o[4] = {};
    const int sr = tid >> 4, sc = (tid & 15) * 8, vst0 = v_st(sr, sc), vst1 = v_st(32 + sr, sc), kws = KSWZ(sr, sc * 2);
    const int vb0 = (int)(uintptr_t)V_lds + v_rd_base(lane);
    const bf16_t* Kh = cur.K; const bf16_t* Vh = cur.V;
    const unsigned moff = (unsigned)((wid * 4 + (r32 >> 3)) * 64 * 8);
    unsigned long long mk = 0;
#define RESC(a) do { if (__any((a) < 1.f)) { if (hi == 0) al_l[r32] = (a); asm volatile("s_waitcnt lgkmcnt(0)" ::: "memory");              \
                     for (int d_ = 0; d_ < 4; ++d_) for (int r = 0; r < 16; ++r) o[d_][r] *= al_l[crow(r, hi)]; } } while (0)
#define KBASE(t) ((t) * KVBLK)
#define MASKT(P0_, P1_, t) do { if (MODE == 0) { const int kb_ = KBASE(t); if (kb_ + KVBLK - 1 > qlo) mask_causal(P0_, P1_, qm - kb_); } else mask_bits(P0_, P1_, mk, hi); } while (0)
#define MLOAD_(t, off) do { if (MODE == 1) mk = *(const unsigned long long*)((const char*)(cur.msk + (t)) + (off)); } while (0)
#define MLOAD(t) MLOAD_(t, moff)
#define BLOAD(X0, X1, t) do { if (MODE == 0 && !(MK_DBG & 2)) { X0 = cur.bias[KBASE(t) + r32]; X1 = cur.bias[KBASE(t) + 32 + r32]; } } while (0)
#define SEAM_K0() do { if (QPRE) VMWN(8); else VMWN(0); SWRITE_HK(0); SBAR(); } while (0)
    f32x16 pA0, pA1, pB0, pB1; float mnA, mnB, alA, alB; bf16x8 pa0, pa1, pa2, pa3;
    float bz0 = 0.f, bz1 = 0.f;
    BLOAD(bz0, bz1, 0);
    SWRITE_HV(0); SBAR();
    if (NT > 1) SLOAD_H(Kh, Vh, KBASE(1));
    MLOAD(0);
    SBAR(); qkt<0, MODE>(pA0, pA1, K_lds, r32, hi, S.qr, bz0, bz1);
    if (NT > 1) BLOAD(bz0, bz1, 1);
    MASKT(pA0, pA1, 0); partialSM(pA0, pA1, m_reg, mnA, alA);
    if (NT > 1) { VMW(); SWRITE_H(1); }
    __syncthreads();
#define HALF_STEP(PX0, PX1, mnX, alX, PY0, PY1, alY, t, KB, VB, SB) do {                                                      \
        MLOAD(t); SBAR(); qkt<KB, MODE>(PX0, PX1, K_lds, r32, hi, S.qr, bz0, bz1);                                            \
        finishSM(PY0, PY1, alY, l_reg, pa0, pa1, pa2, pa3); SBAR();                                                           \
        if ((t) + 1 < NT) { SLOAD_H(Kh, Vh, KBASE((t) + 1)); BLOAD(bz0, bz1, (t) + 1); SBAR(); }                              \
        pv_tile<VB>(o, vb0, pa0, pa1, pa2, pa3); MASKT(PX0, PX1, (t)); partialSM(PX0, PX1, m_reg, mnX, alX);                  \
        __syncthreads();                                                                                                      \
        if ((t) + 1 < NT) { VMW(); SWRITE_H(SB); }                                                                            \
        RESC(alX); __syncthreads(); } while (0)
    for (int t = 1; t + 1 < NT; t += 2) {
        HALF_STEP(pB0, pB1, mnB, alB, pA0, pA1, alA, t, 1, 0, 0);
        HALF_STEP(pA0, pA1, mnA, alA, pB0, pB1, alB, t + 1, 0, 1, 1);
    }
    const bool even = (NT & 1) == 0;
    constexpr bool QPRE = (MODE == 1);
    int tid2 = tid; asm volatile("" : "+v"(tid2));
    const int lane2 = tid2 & 63, r32e = lane2 & 31, hie = lane2 >> 5, sre = tid2 >> 4, sce = (tid2 & 15) * 8;
    const unsigned moffe = (unsigned)((wid * 4 + (r32e >> 3)) * 64 * 8);
    if (even) { MLOAD_(NT - 1, moffe); SBAR(); qkt<1, MODE>(pB0, pB1, K_lds, r32, hi, S.qr, bz0, bz1); SBAR(); }
    { const bf16_t* vp = nxt.V + (size_t)sre * PKV + sce; const bf16_t* kp = nxt.K + (size_t)sre * PKV + sce;
      S.st_v0 = LD8(vp); S.st_v1 = LD8(vp + (size_t)32 * PKV); S.st_k0 = LD8(kp); S.st_k1 = LD8(kp + (size_t)32 * PKV); SBAR();
      if (QPRE) { const bf16_t* qp = nxt.Q + qrow_off<MODE>(wid * QBLK + r32e) + hie * 8;
#pragma unroll
      for (int d0 = 0; d0 < 8; ++d0) S.qr[d0] = LD8(qp + d0 * 16); } }
    SBAR();
    finishSM(pA0, pA1, alA, l_reg, pa0, pa1, pa2, pa3); SBAR();
    pv_tile<0>(o, vb0, pa0, pa1, pa2, pa3);
    if (even) { MASKT(pB0, pB1, NT - 1); partialSM(pB0, pB1, m_reg, mnB, alB); __syncthreads(); RESC(alB);
        finishSM(pB0, pB1, alB, l_reg, pa0, pa1, pa2, pa3); SBAR(); pv_tile<1>(o, vb0, pa0, pa1, pa2, pa3); }
    SBAR(); SEAM_K0();
    if (hie == 0) li_l[r32e] = l_reg; asm volatile("s_waitcnt lgkmcnt(0)" ::: "memory");
    float rli[16];
#pragma unroll
    for (int r = 0; r < 16; ++r) rli[r] = __builtin_amdgcn_rcpf(li_l[crow(r, hie)]);
#pragma unroll
    for (int r = 0; r < 16; ++r) { bf16_t* orow = cur.O + qrow_off<MODE>(wid * QBLK + crow(r, hie));
#pragma unroll
        for (int d0 = 0; d0 < 4; ++d0) { const float v = o[d0][r] * rli[r];
            const float vn = __shfl_xor(v, 1);
            if ((r32e & 1) == 0) *(unsigned*)(orow + d0 * 32 + r32e) = cvtpk(v, vn); } }
    if (!QPRE) { SBAR(); const bf16_t* qp = nxt.Q + qrow_off<MODE>(wid * QBLK + r32e) + hie * 8;
#pragma unroll
        for (int d0 = 0; d0 < 8; ++d0) S.qr[d0] = LD8(qp + d0 * 16); }
    __syncthreads();
#undef RESC
#undef KBASE
#undef MASKT
#undef MLOAD
#undef MLOAD_
#undef BLOAD
#undef SEAM_K0
#undef HALF_STEP
}
template <int MODE>
__device__ __forceinline__ void sblock(const Ref& cur, char* lds) {
    constexpr int PKV = MODE == 0 ? 2048 : 512;
    const int tid = threadIdx.x, wid = __builtin_amdgcn_readfirstlane(tid >> 6), lane = tid & 63, r32 = lane & 31, hi = lane >> 5;
    const int NT = cur.NT;
    const int qlo = cur.P0 + wid * QBLK, qm = qlo + r32 - 4 * hi;
    char* V_lds = lds; char* K_lds = lds + 2 * SHM_V;
    float* ws = (float*)(lds + 2 * SHM_V + 2 * SHM_K) + wid * 64; float* li_l = ws, * al_l = ws + 32;
    float m_reg = -1e30f, l_reg = 0; f32x16 o[4] = {};
    const int sr = tid >> 4, sc = (tid & 15) * 8, vst0 = v_st(sr, sc), vst1 = v_st(32 + sr, sc), kws = KSWZ(sr, sc * 2);
    const int vb0 = (int)(uintptr_t)V_lds + v_rd_base(lane);
    const unsigned moff = (unsigned)((wid * 4 + (r32 >> 3)) * 64 * 8);
    bf16x8 qr[8];
    { const bf16_t* qp = cur.Q + qrow_off<MODE>(wid * QBLK + r32) + hi * 8;
#pragma unroll
      for (int d0 = 0; d0 < 8; ++d0) qr[d0] = LD8(qp + d0 * 16); }
    Seam S;
    SLOAD_H(cur.K, cur.V, 0);
    for (int t = 0; t < NT; ++t) {
        float bz0 = 0.f, bz1 = 0.f; unsigned long long mk = 0;
        if (MODE == 0 && !(MK_DBG & 2)) { bz0 = cur.bias[t * KVBLK + r32]; bz1 = cur.bias[t * KVBLK + 32 + r32]; }
        if (MODE == 1) mk = *(const unsigned long long*)((const char*)(cur.msk + t) + moff);
        __syncthreads();
        VMW(); SWRITE_H(0);
        if (t + 1 < NT) SLOAD_H(cur.K, cur.V, (t + 1) * KVBLK);
        __syncthreads();
        f32x16 p0, p1; float mn, al; bf16x8 pa0, pa1, pa2, pa3;
        qkt<0, MODE>(p0, p1, K_lds, r32, hi, qr, bz0, bz1);
        if (MODE == 0) { const int kb_ = t * KVBLK; if (kb_ + KVBLK - 1 > qlo) mask_causal(p0, p1, qm - kb_); } else mask_bits(p0, p1, mk, hi);
        partialSM(p0, p1, m_reg, mn, al);
        if (__any(al < 1.f)) { if (hi == 0) al_l[r32] = al; asm volatile("s_waitcnt lgkmcnt(0)" ::: "memory");
            for (int d_ = 0; d_ < 4; ++d_) for (int r = 0; r < 16; ++r) o[d_][r] *= al_l[crow(r, hi)]; }
        finishSM(p0, p1, al, l_reg, pa0, pa1, pa2, pa3);
        pv_tile<0>(o, vb0, pa0, pa1, pa2, pa3);
    }
    if (hi == 0) li_l[r32] = l_reg; asm volatile("s_waitcnt lgkmcnt(0)" ::: "memory");
    float rli[16];
#pragma unroll
    for (int r = 0; r < 16; ++r) rli[r] = __builtin_amdgcn_rcpf(li_l[crow(r, hi)]);
#pragma unroll
    for (int r = 0; r < 16; ++r) { bf16_t* orow = cur.O + qrow_off<MODE>(wid * QBLK + crow(r, hi));
#pragma unroll
        for (int d0 = 0; d0 < 4; ++d0) { const float v = o[d0][r] * rli[r];
            const float vn = __shfl_xor(v, 1);
            if ((r32 & 1) == 0) *(unsigned*)(orow + d0 * 32 + r32) = cvtpk(v, vn); } }
    __syncthreads();
}
#undef ROW
#undef VMW
#undef VMWN
#undef LD8
#undef SLOAD_H
#undef SWRITE_HK
#undef SWRITE_HV
#undef SWRITE_H
}

constexpr int NWAVES = 8;
struct Args { const void* in[25]; float* out; unsigned char* ws; int ph_lo, ph_hi; };
#define GAS __attribute__((address_space(1)))
#define CAS __attribute__((address_space(4)))
struct ArgsD { const GAS void* in[25]; GAS float* out; GAS unsigned char* ws; int ph_lo, ph_hi; };
typedef const CAS ArgsD* ArgsP;
__device__ __forceinline__ ArgsP get_args() { unsigned long long p = (unsigned long long)__builtin_amdgcn_kernarg_segment_ptr(); asm volatile("" : "+s"(p)); return (ArgsP)p; }
struct Frame {
    LAS unsigned char* lds; char* ldsg; volatile LAS unsigned* MISC;
    int tid, lane, wave, vcu, G, gw, NGW;
};
enum { I_X = 0, I_P, I_POS, I_GATTN, I_WIN, I_GCQ, I_WUQ, I_WUQI, I_GKIDX, I_BKIDX, I_GQA, I_GKA, I_BFORGET, I_GQB, I_GKB, I_WUPA, I_WUPB, I_WO, I_GFFN, I_WFG, I_WFU, I_WFD, I_GPLE, I_WPLE, I_WPLEG };

constexpr int TR_STRIP = 64 * 65 * 4;
struct TrItem { const float* W; bf16_t* WT; const float* gain; int ldw, K, n0, k0, scol4; };
__device__ __forceinline__ void tr_load(const TrItem& it, f32x4 (&v)[16], int lane) {
    const float* p = it.W + (size_t)(it.k0 + (lane >> 4)) * it.ldw + (it.scol4 < 0 ? 0 : it.scol4);
#pragma unroll
    for (int q = 0; q < 16; ++q) v[q] = __builtin_nontemporal_load((const f32x4*)(p + (size_t)(4 * q) * it.ldw));
    if (it.gain) {
#pragma unroll
        for (int q = 0; q < 16; ++q) v[q] = v[q] * it.gain[it.k0 + 4 * q + (lane >> 4)]; }
    else if (it.scol4 < 0) {
#pragma unroll
        for (int q = 0; q < 16; ++q) v[q] = (f32x4){0.f, 0.f, 0.f, 0.f}; }
}
__device__ __forceinline__ void tr_store(const TrItem& it, const f32x4 (&v)[16], LAS float* scr, int lane) {
    const int cb = (lane & 15) * 4;
#pragma unroll
    for (int q = 0; q < 16; ++q) { LAS float* r = scr + (4 * q + (lane >> 4)) * 65 + cb; r[0] = v[q].x; r[1] = v[q].y; r[2] = v[q].z; r[3] = v[q].w; }
    LDS_WAIT(); asm volatile("" ::: "memory");
    const int c = lane & 7;
#pragma unroll
    for (int j = 0; j < 8; ++j) { const int n = (lane >> 3) + 8 * j; const LAS float* sp = scr + (8 * c) * 65 + n;
        u32x4 o; o.x = pk2(sp[0 * 65], sp[1 * 65]); o.y = pk2(sp[2 * 65], sp[3 * 65]); o.z = pk2(sp[4 * 65], sp[5 * 65]); o.w = pk2(sp[6 * 65], sp[7 * 65]);
        *(u32x4*)(it.WT + (size_t)(it.n0 + n) * it.K + it.k0 + 8 * c) = o; }
    LDS_WAIT(); asm volatile("" ::: "memory");
}
__device__ __forceinline__ int win_src_col(int n) {
    if (n < 1632) return n;
    if (n < 1648) return 7776 + (n - 1632);
    if (n < 1792) return -1;
    if (n < 7936) return 1632 + (n - 1792);
    return 7792 + (n - 7936);
}
__device__ __forceinline__ void rms_row_to_bf16(const float* xrow, const float* g, bf16_t* orow, int lane) {
    const f32x4* xr = (const f32x4*)xrow + lane;
    f32x4 v[16]; float s = 0.f;
#pragma unroll
    for (int j = 0; j < 16; ++j) { v[j] = __builtin_nontemporal_load(xr + 64 * j); s += (v[j].x * v[j].x + v[j].y * v[j].y) + (v[j].z * v[j].z + v[j].w * v[j].w); }
    const float rstd = 1.0f / sqrtf(wave_sum(s) * (1.f / 4096.f) + EPS);
    const f32x4* gr = (const f32x4*)g + lane;
    unsigned long long* o8 = (unsigned long long*)orow + lane;
#pragma unroll
    for (int j = 0; j < 16; ++j) { const f32x4 gg = gr[64 * j];
        o8[64 * j] = (unsigned long long)pk2(v[j].x * rstd * gg.x, v[j].y * rstd * gg.y) | ((unsigned long long)pk2(v[j].z * rstd * gg.z, v[j].w * rstd * gg.w) << 32); }
}
__device__ __forceinline__ void rms_phase(Frame& F, const float* X, const float* g, bf16_t* O) {
    for (int m = F.gw; m < M; m += F.NGW) rms_row_to_bf16(X + (size_t)m * DM, g, O + (size_t)m * DM, F.lane);
}

constexpr int TJ1 = 252 * 64, TJ3 = 64 * 16, TJPL = 64 * 4, TJUP = 64 * 32, TJO = 64 * 64, TJPG = 64 * 64, TJGU = 344 * 64, TJD = 64 * 172;
constexpr int TR_A = TJ1 + TJ3 + TJPL, TR_B = TR_A + 2 * TJUP + TJO, TR_C = TR_B + TJGU, TR_D = TR_C + TJPG + TJD;
__device__ __forceinline__ void tr_convert(Frame& F, ArgsP a, int lo, int hi, int w0, int nw) {
    LAS float* scr = (LAS float*)(F.lds + F.wave * TR_STRIP);
    auto mk = [&](int it) { TrItem t; t.gain = nullptr; int r = it; const int c4 = (F.lane & 15) * 4;
        if (r < TJ1) { const int kb = r / 252, nb = r % 252; t.W = (const float*)a->in[I_WIN]; t.ldw = INW; t.K = DM; t.WT = (bf16_t*)(a->ws + WS_RB); t.n0 = nb * 64; t.k0 = kb * 64; t.scol4 = win_src_col(nb * 64 + c4); return t; } r -= TJ1;
        if (r < TJ3) { const int kb = r / 64, nb = r % 64; t.W = (const float*)a->in[nb >= 32 ? I_WUQI : I_WUQ]; t.ldw = 2048; t.K = QRANK; t.WT = (bf16_t*)(a->ws + WS_W3T); t.n0 = nb * 64; t.k0 = kb * 64; t.scol4 = (nb & 31) * 64 + c4; return t; } r -= TJ3;
        if (r < TJPL) { const int kb = r / 64, nb = r % 64; t.W = (const float*)a->in[I_WPLE]; t.ldw = DM; t.K = PLE; t.WT = (bf16_t*)(a->ws + WS_WPLET); t.n0 = nb * 64; t.k0 = kb * 64; t.scol4 = nb * 64 + c4; return t; } r -= TJPL;
        if (r < 2 * TJUP) { const bool bb = r >= TJUP; if (bb) r -= TJUP; const int kb = r / 64, nb = r % 64; t.W = (const float*)a->in[bb ? I_WUPB : I_WUPA]; t.ldw = DM; t.K = 2048; t.WT = (bf16_t*)(a->ws + (bb ? WS_WUPB : WS_WUPA)); t.n0 = nb * 64; t.k0 = kb * 64; t.scol4 = nb * 64 + c4; return t; } r -= 2 * TJUP;
        if (r < TJO) { const int kb = r / 64, nb = r % 64; t.W = (const float*)a->in[I_WO]; t.ldw = DM; t.K = DM; t.WT = (bf16_t*)(a->ws + WS_WO); t.n0 = nb * 64; t.k0 = kb * 64; t.scol4 = nb * 64 + c4; return t; } r -= TJO;
        if (r < TJGU) { const int kb = r / 344, nb = r % 344; const int n0 = nb * 64, pn = n0 >> 8, rr = n0 & 255; const bool up = rr >= 128;
            t.W = (const float*)a->in[up ? I_WFU : I_WFG]; t.ldw = DFF; t.K = DM; t.WT = (bf16_t*)(a->ws + WS_WGU); t.gain = (const float*)a->in[I_GFFN]; t.n0 = n0; t.k0 = kb * 64; t.scol4 = pn * 128 + (rr & 127) + c4; return t; } r -= TJGU;
        if (r < TJPG) { const int kb = r / 64, nb = r % 64; t.W = (const float*)a->in[I_WPLEG]; t.ldw = DM; t.K = DM; t.WT = (bf16_t*)(a->ws + WS_WPG); t.gain = (const float*)a->in[I_GPLE]; t.n0 = nb * 64; t.k0 = kb * 64; t.scol4 = nb * 64 + c4; return t; } r -= TJPG;
        { const int kb = r / 64, nb = r % 64; t.W = (const float*)a->in[I_WFD]; t.ldw = DM; t.K = DFF; t.WT = (bf16_t*)(a->ws + WS_WD); t.n0 = nb * 64; t.k0 = kb * 64; t.scol4 = nb * 64 + c4; return t; } };
    f32x4 v[16]; int it = lo + w0;
    if (it < hi) { TrItem cur = mk(it); tr_load(cur, v, F.lane);
        for (;;) { const int nx = it + nw; f32x4 w[16];
#pragma unroll
            for (int q = 0; q < 16; ++q) w[q] = v[q];
            TrItem nxt = cur; const bool more = nx < hi; if (more) { nxt = mk(nx); tr_load(nxt, v, F.lane); }
            tr_store(cur, w, scr, F.lane);
            if (!more) break; cur = nxt; it = nx; } }
}

__device__ __forceinline__ void p0_prologue(Frame& F, ArgsP a) {
    tr_convert(F, a, 0, TR_A, F.gw, F.NGW);
    rms_phase(F, (const float*)a->in[I_X], (const float*)a->in[I_GATTN], (bf16_t*)(a->ws + WS_RA));
    { const f32x4* p4 = (const f32x4*)a->in[I_P]; u32x2* o = (u32x2*)(a->ws + WS_PBF);
      for (int i = (blockIdx.x * NWAVES * 64 + F.tid); i < M * PLE / 4; i += F.G * NWAVES * 64) { const f32x4 v = p4[i]; u32x2 w; w.x = pk2(v.x, v.y); w.y = pk2(v.z, v.w); o[i] = w; } }
    { const int* pos = (const int*)a->in[I_POS]; float* ca = (float*)(a->ws + WS_ROPEA); float* sa = ca + (size_t)M * 64; float* ci = (float*)(a->ws + WS_ROPEI); float* si = ci + (size_t)M * 16;
      const double L2T = 13.287712379549449;
      for (int i = (blockIdx.x * NWAVES * 64 + F.tid); i < M * 80; i += F.G * NWAVES * 64) {
          const int m = i / 80, e = i % 80; const bool isA = e < 64; const int k = isA ? e : e - 64;
          const double inv = exp2(-(double)k * (isA ? L2T / 64.0 : L2T / 16.0));
          double rev = (double)pos[m] * inv * 0.15915494309189535; rev -= floor(rev);
          const float fr = (float)rev; const float c = __builtin_amdgcn_cosf(fr), s = __builtin_amdgcn_sinf(fr);
          if (isA) { ca[(size_t)m * 64 + k] = c; sa[(size_t)m * 64 + k] = s; } else { ci[(size_t)m * 16 + k] = c; si[(size_t)m * 16 + k] = s; } } }
}

__device__ __forceinline__ void p2_fixups(Frame& F, ArgsP a) {
    const int lane = F.lane;
    bf16_t* CQ = (bf16_t*)(a->ws + WS_RC); bf16_t* QB = (bf16_t*)(a->ws + WS_RD); bf16_t* KB = QB + (size_t)M * 2048; bf16_t* KVA = (bf16_t*)(a->ws + WS_KVA);
    const float* MISC = (const float*)(a->ws + WS_MISC);
    const float* ca = (const float*)(a->ws + WS_ROPEA); const float* sa = ca + (size_t)M * 64; const float* ci = (const float*)(a->ws + WS_ROPEI); const float* si = ci + (size_t)M * 16;
    bf16_t* KIDX = (bf16_t*)(a->ws + WS_KIDX); float* WIDX = (float*)(a->ws + WS_WIDX);
    const float* gcq = (const float*)a->in[I_GCQ]; const float* gqb = (const float*)a->in[I_GQB]; const float* gkb = (const float*)a->in[I_GKB]; const float* gka = (const float*)a->in[I_GKA];
    const float* gki = (const float*)a->in[I_GKIDX]; const float* bki = (const float*)a->in[I_BKIDX];
    const f32x4 gca = ((const f32x4*)gcq)[2 * lane], gcb = ((const f32x4*)gcq)[2 * lane + 1], gcc = ((const f32x4*)gcq)[2 * lane + 128], gcd = ((const f32x4*)gcq)[2 * lane + 129];
    const int dl = (lane & 15) * 8; const bool hi = (lane & 8) != 0;
    const f32x4 gka0 = *(const f32x4*)(gka + dl), gka1 = *(const f32x4*)(gka + dl + 4);
    const float gkl = gki[lane], bkl = bki[lane];
    for (int m = F.gw; m < M; m += F.NGW) {
        u32x4* pc = (u32x4*)(CQ + (size_t)m * 1024) + lane;
        u32x4* pa = (u32x4*)(KVA + (size_t)m * 512) + (lane & 31);
        const u32x4 w0 = pc[0], w1 = pc[64];
        const u32x4 wa = pa[0];
        const f32x4 c0 = *(const f32x4*)(ca + (size_t)m * 64 + (dl & 63)), c1 = *(const f32x4*)(ca + (size_t)m * 64 + (dl & 63) + 4);
        f32x4 s0 = *(const f32x4*)(sa + (size_t)m * 64 + (dl & 63)), s1 = *(const f32x4*)(sa + (size_t)m * 64 + (dl & 63) + 4);
        const float xi = MISC[(size_t)m * 256 + lane], wi = MISC[(size_t)m * 256 + 64 + (lane & 31)];
        const float cI = ci[(size_t)m * 16 + (lane & 15)], sI = si[(size_t)m * 16 + (lane & 15)];
        asm volatile("" ::: "memory");
        { f32x4 x0, x1, x2, x3; pg8::unpack8f(w0, x0, x1); pg8::unpack8f(w1, x2, x3);
          float s = 0.f;
#pragma unroll
          for (int j = 0; j < 4; ++j) s += x0[j] * x0[j] + x1[j] * x1[j] + x2[j] * x2[j] + x3[j] * x3[j];
          const float rstd = 1.0f / sqrtf(wave_sum(s) * (1.f / 1024.f) + EPS);
          pc[0] = pg8::pack8f(x0 * rstd * gca, x1 * rstd * gcb); pc[64] = pg8::pack8f(x2 * rstd * gcc, x3 * rstd * gcd); }
        { f32x4 x0, x1; pg8::unpack8f(wa, x0, x1);
          float ss = 0.f;
#pragma unroll
          for (int j = 0; j < 4; ++j) ss += x0[j] * x0[j] + x1[j] * x1[j];
          ss += __shfl_xor(ss, 1); ss += __shfl_xor(ss, 2); ss += __shfl_xor(ss, 4); ss += __shfl_xor(ss, 8);
          const float rstd = 1.0f / sqrtf(ss * (1.f / 128.f) + EPS);
          x0 = x0 * rstd * gka0; x1 = x1 * rstd * gka1;
          if (!hi) { s0 = -s0; s1 = -s1; }
          f32x4 y0, y1;
#pragma unroll
          for (int j = 0; j < 4; ++j) { y0[j] = __shfl_xor(x0[j], 8); y1[j] = __shfl_xor(x1[j], 8); }
          if (lane < 32) pa[0] = pg8::pack8f(x0 * c0 + y0 * s0, x1 * c1 + y1 * s1); }
        { const float mu = wave_sum(xi) * (1.f / 64.f); const float d = xi - mu;
          const float rstd = 1.0f / sqrtf(wave_sum(d * d) * (1.f / 64.f) + EPS);
          const float y = d * rstd * gkl + bkl; const float yo = __shfl_xor(y, 16);
          float r = y; if (lane < 16) r = y * cI - yo * sI; else if (lane < 32) r = y * cI + yo * sI;
          KIDX[((((size_t)(m >> 5) * 4 + ((lane >> 3) & 3)) * 64 + (lane >> 5) * 32 + (m & 31)) << 3) + (lane & 7)] = (bf16_t)f2bf(r);
          if (lane < 32) WIDX[(size_t)m * 32 + lane] = wi * 0.022097086912079608f; }
    }
    if (MK_DBG & 2048) { float* bk = (float*)(a->ws + WS_BIASK); const float* bfp = (const float*)a->in[I_BFORGET];
        for (int i = F.gw * 64 + lane; i < BATCH * NH * SEQ; i += F.NGW * 64) { const int bh = i >> 12, sI = i & 4095, b = bh >> 4, h = bh & 15;
            bk[i] = -100.f * (MISC[((size_t)b * SEQ + sI) * 256 + 96 + h] + bfp[h]) * INV_SM_SCALE; } }
    __syncthreads();
    if (blockIdx.x < BATCH * NH && !(MK_DBG & 2048) && (MK_P2MASK & 16)) {
        const int bh = blockIdx.x, b = bh / NH, h = bh % NH; const float bf = (MK_P2MASK & 32) ? 2.5f : ((const float*)a->in[I_BFORGET])[h];
        LAS float* lf = (LAS float*)(F.lds);
        for (int sIdx = F.tid; sIdx < SEQ; sIdx += NWAVES * 64) { const float x = MISC[((size_t)b * SEQ + sIdx) * 256 + 96 + h] + bf; lf[sIdx] = (MK_DBG & 128) ? x : fminf(x, 0.f) - log1pf(expf(-fabsf(x))); if (MK_DBG & 1024) ((float*)(a->ws + WS_BIASK))[(size_t)bh * SEQ + sIdx] = -100.f * x * INV_SM_SCALE; }
        __syncthreads();
        if (F.wave == 0) {
            float tot = 0.f;
            for (int j = 0; j < 64; ++j) tot += lf[lane * 64 + j];
            float inc = tot;
#pragma unroll
            for (int o = 1; o < 64; o <<= 1) { const float t = __shfl_up(inc, o); if (lane >= o) inc += t; }
            float run = inc - tot;
            float* bk = (float*)(a->ws + WS_BIASK) + (size_t)bh * SEQ + lane * 64;
            for (int j = 0; j < 64; ++j) { if (MK_DBG & 256) run = 100.f * lf[lane * 64 + j]; else run += lf[lane * 64 + j]; if (!(MK_DBG & 1024)) bk[j] = -run * INV_SM_SCALE; }
        }
        __syncthreads();
    }
}

__device__ __forceinline__ void p4_qa_fixup(Frame& F, ArgsP a) {
    const int lane = F.lane, dl = (lane & 15) * 8; bf16_t* QA = (bf16_t*)(a->ws + WS_RA);
    const float* ca = (const float*)(a->ws + WS_ROPEA); const float* sa = ca + (size_t)M * 64; const float* gqa = (const float*)a->in[I_GQA];
    const f32x4 g0 = *(const f32x4*)(gqa + dl), g1 = *(const f32x4*)(gqa + dl + 4); const bool hi = (lane & 8) != 0;
    for (int m = F.gw; m < M; m += F.NGW) { u32x4* p = (u32x4*)(QA + (size_t)m * 2048) + lane;
        u32x4 w[4];
#pragma unroll
        for (int c = 0; c < 4; ++c) w[c] = p[64 * c];
        const f32x4 c0 = *(const f32x4*)(ca + (size_t)m * 64 + (dl & 63)), c1 = *(const f32x4*)(ca + (size_t)m * 64 + (dl & 63) + 4);
        f32x4 s0 = *(const f32x4*)(sa + (size_t)m * 64 + (dl & 63)), s1 = *(const f32x4*)(sa + (size_t)m * 64 + (dl & 63) + 4);
        asm volatile("" ::: "memory");
        if (!hi) { s0 = -s0; s1 = -s1; }
#pragma unroll
        for (int c = 0; c < 4; ++c) { f32x4 x0, x1; pg8::unpack8f(w[c], x0, x1);
            float ss = 0.f;
#pragma unroll
            for (int j = 0; j < 4; ++j) ss += x0[j] * x0[j] + x1[j] * x1[j];
            ss += __shfl_xor(ss, 1); ss += __shfl_xor(ss, 2); ss += __shfl_xor(ss, 4); ss += __shfl_xor(ss, 8);
            const float rstd = 1.0f / sqrtf(ss * (1.f / 128.f) + EPS);
            x0 = x0 * rstd * g0; x1 = x1 * rstd * g1;
            f32x4 y0, y1;
#pragma unroll
            for (int j = 0; j < 4; ++j) { y0[j] = __shfl_xor(x0[j], 8); y1[j] = __shfl_xor(x1[j], 8); }
            p[64 * c] = pg8::pack8f(x0 * c0 + y0 * s0, x1 * c1 + y1 * s1); } }
}

__device__ __forceinline__ int wave_sum_i32(int v) {
    v += __builtin_amdgcn_update_dpp(0, v, 0x111, 0xf, 0xf, true);
    v += __builtin_amdgcn_update_dpp(0, v, 0x112, 0xf, 0xf, true);
    v += __builtin_amdgcn_update_dpp(0, v, 0x114, 0xf, 0xf, true);
    v += __builtin_amdgcn_update_dpp(0, v, 0x118, 0xf, 0xf, true);
    return __builtin_amdgcn_readlane(v, 15) + __builtin_amdgcn_readlane(v, 31) + __builtin_amdgcn_readlane(v, 47) + __builtin_amdgcn_readlane(v, 63);
}
__device__ __forceinline__ unsigned sortable_u(float v) { const unsigned b = __float_as_uint(v); return (b & 0x80000000u) ? ~b : (b | 0x80000000u); }
__device__ __forceinline__ void indexer_query(Frame& F, ArgsP a, int b, int t) {
    const int lane = F.lane, n = lane & 31, kg = lane >> 5;
    const size_t row = (size_t)b * SEQ + t;
    const int nt = (t >> 6) + 1;
    LAS float* sc = (LAS float*)(F.lds + F.wave * 16384);
    const bf16_t* QI = (const bf16_t*)(a->ws + WS_RA) + (size_t)M * 2048; const bf16_t* KIDX = (const bf16_t*)(a->ws + WS_KIDX);
    const float* WIDX = (const float*)(a->ws + WS_WIDX); const float* ci = (const float*)(a->ws + WS_ROPEI); const float* si = ci + (size_t)M * 16;
    unsigned long long* SELM = (unsigned long long*)(a->ws + WS_SELM);
    bf16x8 af[4];
    { const bf16_t* qp = QI + row * 2048 + n * 64 + kg * 32;
#pragma unroll
      for (int s = 0; s < 4; ++s) af[s] = *(const bf16x8*)(qp + 8 * s);
      float x[32];
#pragma unroll
      for (int s = 0; s < 4; ++s)
#pragma unroll
          for (int j = 0; j < 8; ++j) x[8 * s + j] = bf2f((unsigned short)af[s][j]);
      const f32x4* c4 = (const f32x4*)(ci + row * 16); const f32x4* s4 = (const f32x4*)(si + row * 16);
      float y[32];
#pragma unroll
      for (int q = 0; q < 4; ++q) { const f32x4 cc = c4[q], ss = s4[q];
#pragma unroll
          for (int j = 0; j < 4; ++j) { const int i = 4 * q + j; y[i] = x[i] * cc[j] - x[i + 16] * ss[j]; y[i + 16] = x[i + 16] * cc[j] + x[i] * ss[j]; } }
      if (kg == 0) {
#pragma unroll
          for (int s = 0; s < 4; ++s) { u32x4 w; w.x = pk2(y[8 * s], y[8 * s + 1]); w.y = pk2(y[8 * s + 2], y[8 * s + 3]); w.z = pk2(y[8 * s + 4], y[8 * s + 5]); w.w = pk2(y[8 * s + 6], y[8 * s + 7]);
              af[s] = *reinterpret_cast<bf16x8*>(&w); } } }
    typedef float f32x2_t __attribute__((ext_vector_type(2)));
    f32x2_t wp2[8];
    { const float* wp = WIDX + row * 32 + 4 * kg;
#pragma unroll
      for (int j = 0; j < 4; ++j) { const f32x4 w = *(const f32x4*)(wp + 8 * j); wp2[2 * j] = (f32x2_t){w[0], w[1]}; wp2[2 * j + 1] = (f32x2_t){w[2], w[3]}; } }
    const bf16_t* kp = KIDX + (size_t)b * SEQ * 64 + lane * 8;
#define IDX_MMA(BX, cA, cB) do { _Pragma("unroll") for (int s = 0; s < 4; ++s) { cA = __builtin_amdgcn_mfma_f32_32x32x16_bf16(af[s], BX[s], cA, 0, 0, 0); cB = __builtin_amdgcn_mfma_f32_32x32x16_bf16(af[s], BX[4 + s], cB, 0, 0, 0); } } while (0)
#define IDX_SUM(cA, cB, i_) do { f32x2_t aA = {0.f, 0.f}, aB = {0.f, 0.f}; \
        _Pragma("unroll") for (int j = 0; j < 8; ++j) { \
            f32x2_t rA, rB; rA.x = __int_as_float(max(__float_as_int(cA[2 * j]), 0)); rA.y = __int_as_float(max(__float_as_int(cA[2 * j + 1]), 0)); \
            rB.x = __int_as_float(max(__float_as_int(cB[2 * j]), 0)); rB.y = __int_as_float(max(__float_as_int(cB[2 * j + 1]), 0)); \
            aA = __builtin_elementwise_fma(wp2[j], rA, aA); aB = __builtin_elementwise_fma(wp2[j], rB, aB); } \
        const float sA = aA.x + aA.y, sB = aB.x + aB.y; \
        auto rr = __builtin_amdgcn_permlane32_swap(__float_as_uint(sA), __float_as_uint(sB), false, false); \
        sc[(i_) * 64 + lane] = __uint_as_float(sortable_u(__uint_as_float(rr[0]) + __uint_as_float(rr[1]))); } while (0)
#define IDX_LOAD(BX, i_) do { const bf16_t* kn_ = kp + (size_t)(i_) * 4096; \
        _Pragma("unroll") for (int s = 0; s < 4; ++s) { BX[s] = *(const bf16x8*)(kn_ + 512 * s); BX[4 + s] = *(const bf16x8*)(kn_ + 2048 + 512 * s); } } while (0)
    bf16x8 bX[8], bY[8];
    IDX_LOAD(bX, 0); IDX_LOAD(bY, nt > 1 ? 1 : 0);
    for (int i = 0; i < nt; i += 2) {
        f32x16 cA = {}, cB = {}, cC = {}, cD = {};
        IDX_MMA(bX, cA, cB); IDX_LOAD(bX, i + 2 < nt ? i + 2 : nt - 1);
        IDX_MMA(bY, cC, cD); IDX_LOAD(bY, i + 3 < nt ? i + 3 : nt - 1);
        IDX_SUM(cA, cB, i); IDX_SUM(cC, cD, i + 1);
    }
#undef IDX_MMA
#undef IDX_SUM
#undef IDX_LOAD
    unsigned u[64];
#pragma unroll
    for (int i = 0; i < 64; ++i) u[i] = __float_as_uint(sc[i * 64 + lane]);
    asm volatile("" ::: "memory");
#pragma unroll
    for (int i = 0; i < 64; ++i) u[i] = (i < nt) ? u[i] : 0u;
    unsigned mlo = 0u, mhi = 0u;
    if (nt <= TOPK / 64) { if (lane < nt) { mlo = 0xffffffffu; mhi = 0xffffffffu; } }
    else {
        unsigned T = 0u;
        for (int bit = 31; bit >= 0; --bit) {
            const unsigned cand = T | (1u << bit); int cl = 0;
#pragma unroll
            for (int g = 0; g < 8; ++g) { if (g * 8 < nt) {
#pragma unroll
                for (int i = 0; i < 8; ++i) cl += (u[g * 8 + i] >= cand) ? 1 : 0; }
                __builtin_amdgcn_sched_barrier(0); }
            const int c = wave_sum_i32(cl);
            if (c >= TOPK) { T = cand; if (c == TOPK) break; }
        }
        int cgt = 0;
#pragma unroll
        for (int g = 0; g < 8; ++g) { if (g * 8 < nt) {
#pragma unroll
            for (int i = 0; i < 8; ++i) cgt += __popcll(__ballot(u[g * 8 + i] > T)); }
            __builtin_amdgcn_sched_barrier(0); }
        int need = TOPK - cgt;
#pragma unroll
        for (int g = 0; g < 8; ++g) { if (g * 8 < nt) {
#pragma unroll
            for (int i8 = 0; i8 < 8; ++i8) { const int i = g * 8 + i8;
                unsigned long long mk = __ballot(u[i] > T); unsigned long long eq = __ballot(u[i] == T);
                if (eq) { int ce = __popcll(eq);
                    if (ce > need) { int drop = ce - need; while (drop-- > 0) eq &= ~(1ull << (63 - __clzll((long long)eq))); ce = need; }
                    need -= ce; mk |= eq; }
                if (lane == i) { mlo = (unsigned)mk; mhi = (unsigned)(mk >> 32); } } }
            __builtin_amdgcn_sched_barrier(0); }
    }
    SELM[row * 64 + lane] = ((unsigned long long)mhi << 32) | mlo;
}

__device__ __forceinline__ void naive_attn_row(int lane, const bf16_t* q, const bf16_t* K, const bf16_t* V, int pitch, int nk, const float* bias, const unsigned long long* msk, bf16_t* out, LAS float* pl, const float* lfp = nullptr, float bfv = 0.f) {
    u32x4 qv[16];
#pragma unroll
    for (int i = 0; i < 16; ++i) qv[i] = *(const u32x4*)(q + 8 * i);
    float mx = -3.0e38f; float carry = 0.f;
    for (int c = 0; c * 64 < nk; ++c) { const int sk = c * 64 + lane; bool valid = sk < nk; if (msk) valid = valid && ((msk[c] >> lane) & 1ull);
        float fb = 0.f;
        if (lfp) { const float xx = lfp[(size_t)sk * 256] + bfv; float inc = fminf(xx, 0.f) - log1pf(expf(-fabsf(xx)));
            for (int o = 1; o < 64; o <<= 1) { const float tt = __shfl_up(inc, o); if (lane >= o) inc += tt; }
            fb = -(carry + inc) * INV_SM_SCALE; carry += __shfl(inc, 63); }
        float dot = 0.f;
        if (sk < nk) { const u32x4* kr = (const u32x4*)(K + (size_t)sk * pitch);
#pragma unroll
            for (int i = 0; i < 16; ++i) { const u32x4 kv = kr[i];
                dot += bflo(qv[i].x) * bflo(kv.x) + bfhi(qv[i].x) * bfhi(kv.x) + bflo(qv[i].y) * bflo(kv.y) + bfhi(qv[i].y) * bfhi(kv.y)
                     + bflo(qv[i].z) * bflo(kv.z) + bfhi(qv[i].z) * bfhi(kv.z) + bflo(qv[i].w) * bflo(kv.w) + bfhi(qv[i].w) * bfhi(kv.w); } }
        float lg = valid ? (dot + (lfp ? fb : (bias ? bias[sk] : 0.f))) * SM_SCALE : -3.0e38f;
        pl[c * 64 + lane] = lg; mx = fmaxf(mx, lg); }
#pragma unroll
    for (int o = 1; o < 64; o <<= 1) mx = fmaxf(mx, __shfl_xor(mx, o));
    float ls = 0.f;
    for (int c = 0; c * 64 < nk; ++c) { const float lg = pl[c * 64 + lane]; const float p = lg > -1.0e38f ? __expf(lg - mx) : 0.f; pl[c * 64 + lane] = p; ls += p; }
    ls = wave_sum(ls);
    asm volatile("s_waitcnt lgkmcnt(0)" ::: "memory");
    float o0 = 0.f, o1 = 0.f; const int nkr = ((nk + 63) / 64) * 64;
    for (int sk = 0; sk < nkr && sk < nk; ++sk) { const float p = pl[sk]; const unsigned vv = *(const unsigned*)(V + (size_t)sk * pitch + 2 * lane); o0 += p * bflo(vv); o1 += p * bfhi(vv); }
    const float inv = 1.0f / ls;
    *(unsigned*)(out + 2 * lane) = pk2(o0 * inv, o1 * inv);
}
__device__ __forceinline__ void dbg_check_proj(Frame& F, ArgsP a) {
    const int lane = F.lane; LAS float* hv = (LAS float*)(F.lds + F.wave * 16384);
    const float* X_ = (const float*)a->in[I_X]; const float* W = (const float*)a->in[I_WIN]; const float* ga = (const float*)a->in[I_GATTN];
    unsigned* flag = (unsigned*)(a->ws + WS_CTL) + 8;
    const bf16_t* QB = (const bf16_t*)(a->ws + WS_RD); const bf16_t* KB = QB + (size_t)M * 2048; const bf16_t* VB = KB + (size_t)M * 2048; const bf16_t* GT = (const bf16_t*)(a->ws + WS_RG);
    const float* gqb = (const float*)a->in[I_GQB]; const float* gkb = (const float*)a->in[I_GKB];
    if (MK_CHECK & 2) { const bf16_t* W1T = (const bf16_t*)(a->ws + WS_RB);
        for (int it = F.gw; it < 64; it += F.NGW) { const int half = it & 1, n = 7936 + 256 * (it >> 1) + 128 * half + 5 * (it >> 1) % 128; const int src = 7792 + (n - 7936);
            bool bad = false;
            for (int k = lane; k < DM; k += 64) { const unsigned short e = (unsigned short)f2bf(W[(size_t)k * INW + src]); if (e != W1T[(size_t)n * DM + k]) bad = true; }
            if (__any(bad) && lane == 0) atomicOr(flag, half ? 256u : 128u); } }
    for (int smp = F.gw; smp < 256; smp += F.NGW) { const int m = smp * 64 + (smp * 7) % 61;
        float ss = 0.f; for (int k = lane; k < DM; k += 64) { const float v = X_[(size_t)m * DM + k]; ss += v * v; }
        const float rstd = 1.0f / sqrtf(wave_sum(ss) * (1.f / DM) + EPS);
        for (int k = lane; k < DM; k += 64) hv[k] = bf2f((unsigned short)f2bf(X_[(size_t)m * DM + k] * rstd * ga[k]));
        asm volatile("s_waitcnt lgkmcnt(0)" ::: "memory");
#pragma unroll 1
        for (int gI = 0; gI < 6; ++gI) { float a0 = 0.f, a1 = 0.f;
            const int scol = gI == 0 ? 0 : gI == 1 ? 128 : gI == 2 ? 1632 + 256 : gI == 3 ? 1632 + 2048 + 1024 : gI == 4 ? 1632 + 4096 : 1024;
            const float* wp = W + scol + 2 * lane;
#pragma unroll 2
            for (int k = 0; k < DM; ++k) { const float hk = hv[k]; const f32x2 w2 = *(const f32x2*)(wp + (size_t)k * INW); a0 += hk * bf2f((unsigned short)f2bf(w2.x)); a1 += hk * bf2f((unsigned short)f2bf(w2.y)); }
            const float e0 = a0, e1 = a1;
            const bf16_t* gp = gI == 0 ? (const bf16_t*)(a->ws + WS_RC) + (size_t)m * 1024 : gI == 1 ? (const bf16_t*)(a->ws + WS_RC) + (size_t)m * 1024 + 128 : gI == 2 ? QB + (size_t)m * 2048 + 256 : gI == 3 ? KB + (size_t)m * 2048 + 1024 : gI == 4 ? VB + (size_t)m * 2048 : (const bf16_t*)(a->ws + WS_KVA) + (size_t)m * 512;
            const unsigned got = *(const unsigned*)(gp + 2 * lane); const float g0 = bflo(got), g1 = bfhi(got);
            const bool bad = fabsf(g0 - e0) > 0.03f + 0.02f * fabsf(e0) || fabsf(g1 - e1) > 0.03f + 0.02f * fabsf(e1);
            if (__any(bad) && lane == 0) atomicOr(flag, 1u << gI); }
    }
}
__device__ __forceinline__ int snake(int j, int w, int G) { return j * G + ((j & 1) ? (G - 1 - w) : w); }
__device__ __forceinline__ int q_grab(Frame& F, unsigned* head, int& par) {
    if (F.tid == 0) F.MISC[32 + par] = atomicAdd(head, 1u);
    __syncthreads();
    const int v = (int)F.MISC[32 + par]; par ^= 1; return v;
}
__device__ __forceinline__ fa::Ref fox_ref(int L, bf16_t* RD, const float* biasK, float thr, int lane) {
    const int qb = 15 - (L >> 6), bh = L & 63, b = bh >> 4, h = bh & 15; fa::Ref r;
    const size_t base = (size_t)b * SEQ * 2048 + (size_t)h * 128;
    const float* bp = biasK + (size_t)bh * SEQ; const int t0 = qb * 256, nj = qb * 4;
    const float bt = bp[t0], bj = bp[64 * (lane < nj ? lane : 0) + 63];
    const unsigned long long sk = __ballot(lane < nj && (bt - bj) * SM_SCALE > thr);
    const int T0 = sk == ~0ull ? 64 : __builtin_ctzll(~sk);
    r.Q = RD + base + (size_t)qb * 256 * 2048; r.O = RD + base + (size_t)qb * 256 * 2048;
    r.K = RD + (size_t)M * 2048 + base + (size_t)T0 * 64 * 2048; r.V = RD + (size_t)2 * M * 2048 + base + (size_t)T0 * 64 * 2048;
    r.bias = bp + T0 * 64; r.msk = nullptr; r.P0 = t0 - T0 * 64; r.NT = (qb + 1) * 4 - T0; return r;
}
__device__ __forceinline__ fa::Ref dsa_ref(int L, bf16_t* RA, const bf16_t* KVA, const unsigned long long* SELM) {
    const int c = 63 - (L >> 4), r = L & 15, b = r >> 2, g = (r >> 1) & 1, hf = r & 1; const int t0 = c * 64 + hf * 32; fa::Ref q;
    q.Q = RA + ((size_t)b * SEQ + t0) * 2048 + (size_t)g * 8 * 128; q.O = RA + (size_t)M * 2048 + ((size_t)b * SEQ + t0) * 2048 + (size_t)g * 8 * 128;
    q.K = KVA + (size_t)b * SEQ * 512 + (size_t)g * 128; q.V = KVA + (size_t)b * SEQ * 512 + 256 + (size_t)g * 128;
    q.bias = nullptr; q.msk = SELM + ((size_t)b * SEQ + t0) * 64; q.P0 = 0; q.NT = c + 1; return q;
}

constexpr int NPH = 13;
__global__ void __launch_bounds__(NWAVES * 64, 2) mk_fwd(Args args) {
    extern __shared__ __attribute__((aligned(16))) unsigned char lds[];
    Frame F;
    F.lds = (LAS unsigned char*)lds; F.ldsg = (char*)lds;
    F.MISC = (volatile LAS unsigned*)(F.lds + MISC_OFF);
    F.tid = threadIdx.x; F.lane = F.tid & 63; F.wave = __builtin_amdgcn_readfirstlane(F.tid >> 6);
    F.G = gridDim.x; { const int bx = blockIdx.x; F.vcu = (F.G % 8 == 0) ? (bx % 8) * (F.G / 8) + bx / 8 : bx; }
    F.gw = F.vcu * NWAVES + F.wave; F.NGW = F.G * NWAVES;
    ArgsP a = get_args();
    unsigned* ctl = (unsigned*)(a->ws + WS_CTL);
    for (int u = F.tid; u < (LDS_BYTES - LDSCTL_OFF) / 4; u += NWAVES * 64) ((LAS unsigned*)(F.lds + LDSCTL_OFF))[u] = 0u;
    __syncthreads();
    XcdBarrier bar; bar.bar = ctl + CW_BAR; bar.x = 0; bar.st = nullptr;
    if (MK_N_LAUNCHES == 1) bar = xcd_barrier_post(ctl + CW_BAR, F.MISC + 8);
    const int lo = a->ph_lo, hi = a->ph_hi;
#define IN(k) (((MK_PHASE_MASK >> (k)) & 1) && lo <= (k) && (k) < hi)
#define SEAM(k) do { if (IN(k) && IN((k) + 1)) xcd_barrier(bar); } while (0)
#define X ((const float*)a->in[I_X])
#define OUT ((float*)a->out)
#define RA ((bf16_t*)(a->ws + WS_RA))
#define RB ((bf16_t*)(a->ws + WS_RB))
#define RC ((bf16_t*)(a->ws + WS_RC))
#define RD ((bf16_t*)(a->ws + WS_RD))
#define RG ((bf16_t*)(a->ws + WS_RG))
#define KVA ((bf16_t*)(a->ws + WS_KVA))

    if (MK_CHECK && lo == 100) { a = get_args(); dbg_check_proj(F, a); return; }

    if (IN(0)) { a = get_args(); p0_prologue(F, a); } SEAM(0);

    if (IN(1)) { a = get_args();
        pg8::Gemm g{RA, RB, nullptr, nullptr, M, N1, DM}; pg8::StaticOrder S; S.init(M, N1, F.G, (int)blockIdx.x);
        pg8::EpiP1 E{RC, KVA, RD, RG, (float*)(a->ws + WS_MISC), (const float*)a->in[I_GQB], (const float*)a->in[I_GKB], (LAS float*)(F.lds + RING_BYTES)};
        pg8::gemm_phase<pg8::EpiP1, pg8::StaticOrder>(F.lds, g, S, E);
        { const int rem = S.nwg % F.G, c = (int)blockIdx.x;
          if (rem == 0) tr_convert(F, a, TR_A, TR_B, c * NWAVES + F.wave, F.G * NWAVES);
          else if (c >= rem) tr_convert(F, a, TR_A, TR_B, (c - rem) * NWAVES + F.wave, (F.G - rem) * NWAVES); }
    } SEAM(1);

    if (IN(2)) { a = get_args(); if (MK_DBG & 512) { for (int q = 0; q < 600; ++q) __builtin_amdgcn_s_sleep(127); } p2_fixups(F, a); } SEAM(2);

    if (IN(3)) { a = get_args();
        pg8::Gemm g{RC, (const bf16_t*)(a->ws + WS_W3T), nullptr, nullptr, M, 4096, QRANK}; pg8::StaticOrder S; S.init(M, 4096, F.G, (int)blockIdx.x);
        pg8::EpiBf16 E{RA, 2048, 2048, (size_t)M * 2048};
        pg8::gemm_phase<pg8::EpiBf16, pg8::StaticOrder>(F.lds, g, S, E);
        if (MK_NAIVE & 1) { LAS float* pl = (LAS float*)(F.lds + F.wave * 16384); constexpr int NHN = 4; bf16_t* TMP = RB; const float* biasK = (const float*)(a->ws + WS_BIASK);
            for (int it = F.gw; it < M * NHN; it += F.NGW) { const int m = it / NHN, h = it % NHN, b = m / SEQ, t = m % SEQ;
                const bf16_t* qp = RD + (size_t)m * 2048 + h * 128; const size_t kb = (size_t)b * SEQ * 2048 + h * 128;
                naive_attn_row(F.lane, qp, RD + (size_t)M * 2048 + kb, RD + (size_t)2 * M * 2048 + kb, 2048, t + 1, biasK + (size_t)(b * NH + h) * SEQ, nullptr, TMP + (size_t)m * 512 + h * 128, pl,
                    (const float*)(a->ws + WS_MISC) + (size_t)b * SEQ * 256 + 96 + h, ((const float*)a->in[I_BFORGET])[h]); } }
    } SEAM(3);

    if (IN(4)) { a = get_args();
        if (MK_DBG & 8) { for (int u = 135168 / 4 + F.tid; u < LDS_BYTES / 4; u += NWAVES * 64) ((LAS unsigned*)F.lds)[u] = 0u; __syncthreads(); }
        if (MK_DBG & 16) { for (int q = 0; q < 64; ++q) __builtin_amdgcn_s_sleep(64); }
        if (MK_ATTN & 1) {
            const float* biasK = (const float*)(a->ws + WS_BIASK);
            float thr;
            { const float* gq = (const float*)a->in[I_GQB]; const float* gk = (const float*)a->in[I_GKB];
              float mq = fmaxf(fabsf(gq[F.lane]), fabsf(gq[F.lane + 64])), mk_ = fmaxf(fabsf(gk[F.lane]), fabsf(gk[F.lane + 64]));
#pragma unroll
              for (int o = 1; o < 64; o <<= 1) { mq = fmaxf(mq, __shfl_xor(mq, o)); mk_ = fmaxf(mk_, __shfl_xor(mk_, o)); }
              thr = 2.0f * 11.313708499f * 1.03f * mq * mk_ + 96.0f; }
#define mkref(L) fox_ref((L), RD, biasK, thr, F.lane)
            { unsigned* qh = (unsigned*)(a->ws + WS_CTL) + CW_QFOX; int par = 0;
              const int L0 = q_grab(F, qh, par);
              if (L0 < 1024) { fa::Seam S; fa::Ref cur = mkref(L0);
                  fa::prime<0>(cur, F.ldsg, S);
                  for (;;) { const int Ln = q_grab(F, qh, par); const bool has = Ln < 1024; const fa::Ref nxt = has ? mkref(Ln) : cur;
                      fa::block<0>(cur, nxt, F.ldsg, S); if (!has) break; cur = nxt; } } }
#undef mkref
        } else if (!(MK_ATTN & 4)) {
            u32x4* z = (u32x4*)RD; const u32x4 zz = {0u, 0u, 0u, 0u};
            for (size_t i = (size_t)blockIdx.x * 512 + F.tid; i < (size_t)M * 2048 / 8; i += (size_t)F.G * 512) z[i] = zz;
        }
        if (MK_ATTN & 2) {
            const int NR = 2048 / F.G;
            if (MK_DBG & 1) { unsigned long long* sm = (unsigned long long*)(a->ws + WS_SELM);
                for (size_t i = (size_t)blockIdx.x * 512 + F.tid; i < (size_t)M * 64; i += (size_t)F.G * 512) sm[i] = ~0ull; }
            else
            { unsigned* qh = (unsigned*)(a->ws + WS_CTL) + CW_QIDX; int par = 0;
              int L = q_grab(F, qh, par);
              while (L < 2048) { unsigned tok = 0u; if (F.tid == 0) tok = atomicAdd(qh, 1u);
                  { const int c = 63 - (L >> 5), r = L & 31, b = r >> 3, oc = r & 7; indexer_query(F, a, b, c * 64 + oc * 8 + F.wave); }
                  if (F.tid == 0) F.MISC[32 + par] = tok;
                  __syncthreads(); L = (int)F.MISC[32 + par]; par ^= 1; } }
            p4_qa_fixup(F, a);
        }
        if (MK_ATTN & 4) p4_qa_fixup(F, a);
        if (MK_DBG & 32) { const float* bk = (const float*)(a->ws + WS_BIASK);
            for (int it = F.gw; it < M * NH; it += F.NGW) { const int m = it >> 4, h = it & 15, b = m / SEQ, t = m % SEQ;
                const float v = (MK_DBG & 4096) ? ((const float*)a->in[I_BFORGET])[h] : (MK_DBG & 64) ? ((const float*)(a->ws + WS_MISC))[(size_t)m * 256 + 96 + h] : bk[(size_t)(b * NH + h) * SEQ + t] * 1e-3f; *(unsigned*)(RD + (size_t)m * 2048 + h * 128 + 2 * F.lane) = pk2(v, -v); } }
    } SEAM(4);

    if (IN(5)) { a = get_args();
        if (MK_NAIVE & 1) { constexpr int NHN = 4; const bf16_t* TMP = RB;
            for (int it = F.gw; it < M * NHN; it += F.NGW) { const int m = it / NHN, h = it % NHN;
                *(unsigned*)(RD + (size_t)m * 2048 + h * 128 + 2 * F.lane) = *(const unsigned*)(TMP + (size_t)m * 512 + h * 128 + 2 * F.lane); } }
        if (MK_DBG & 4) { for (int u = 135168 / 4 + F.tid; u < LDS_BYTES / 4; u += NWAVES * 64) ((LAS unsigned*)F.lds)[u] = 0u; __syncthreads(); }
        if (MK_ATTN & 2) {
            const unsigned long long* SELM = (const unsigned long long*)(a->ws + WS_SELM);
#define mkref(L) dsa_ref((L), RA, KVA, SELM)
            const int NR = 1024 / F.G;
            if (NR * F.G == 1024) {
                if (MK_NAIVE & 2) { LAS float* pl = (LAS float*)(F.lds + F.wave * 16384);
                    for (int it = F.gw; it < M * 8; it += F.NGW) { const int m = it >> 3, h = it & 7, b = m / SEQ, t = m % SEQ;
                        const bf16_t* kv = KVA + (size_t)b * SEQ * 512;
                        naive_attn_row(F.lane, RA + (size_t)m * 2048 + h * 128, kv, kv + 256, 512, ((t >> 6) + 1) * 64, nullptr, SELM + (size_t)m * 64, RA + (size_t)M * 2048 + (size_t)m * 2048 + h * 128, pl); }
                    __syncthreads();
                    for (int j = 0; j < NR; ++j) { const int L = snake(j, (int)blockIdx.x, F.G); if (((L >> 1) & 1) == 1) { const fa::Ref cur = mkref(L); fa::sblock<1>(cur, F.ldsg); } } }
                else if (MK_SIMPLE) { for (int j = 0; j < NR; ++j) { const fa::Ref cur = mkref(snake(j, (int)blockIdx.x, F.G)); fa::sblock<1>(cur, F.ldsg); } }
                else {
                fa::Seam S; fa::Ref cur = mkref(snake(0, (int)blockIdx.x, F.G));
                fa::prime<1>(cur, F.ldsg, S);
                for (int j = 0; j < NR; ++j) { const fa::Ref nxt = (j + 1 < NR) ? mkref(snake(j + 1, (int)blockIdx.x, F.G)) : cur;
                    fa::block<1>(cur, nxt, F.ldsg, S); cur = nxt; } }
            }
#undef mkref
        } else if (!(MK_ATTN & 4)) {
            u32x4* z = (u32x4*)(RA + (size_t)M * 2048); const u32x4 zz = {0u, 0u, 0u, 0u};
            for (size_t i = (size_t)blockIdx.x * 512 + F.tid; i < (size_t)M * 2048 / 8; i += (size_t)F.G * 512) z[i] = zz;
        }
    } SEAM(5);

    if (IN(6)) { a = get_args();
        pg8::Gemm g{(MK_ATTN & 8) ? RD + (size_t)M * 2048 : RA + (size_t)M * 2048, (const bf16_t*)(a->ws + WS_WUPA), (MK_ATTN & 8) ? RD + (size_t)2 * M * 2048 : RD, (const bf16_t*)(a->ws + WS_WUPB), M, DM, 2048}; pg8::DualOrder S; S.init(M, DM, F.G, (int)blockIdx.x);
        pg8::EpiMerge E{RG, (MK_ATTN & 8) ? RA : RD + (size_t)M * 2048, RB};
        pg8::gemm_phase<pg8::EpiMerge, pg8::DualOrder>(F.lds, g, S, E);
    } SEAM(6);

    if (IN(7)) { a = get_args();
        pg8::Gemm g{RB, (const bf16_t*)(a->ws + WS_WO), nullptr, nullptr, M, DM, DM}; pg8::StaticOrder S; S.init(M, DM, F.G, (int)blockIdx.x);
        pg8::EpiResidNorm<false> E{X, (bf16_t*)(a->ws + WS_H2), (float*)(a->ws + WS_SS)};
        pg8::gemm_phase<pg8::EpiResidNorm<false>, pg8::StaticOrder>(F.lds, g, S, E);
        tr_convert(F, a, TR_B, TR_C, F.gw, F.NGW);
    } SEAM(7);

    if (IN(9)) { a = get_args();
        pg8::Gemm g{(const bf16_t*)(a->ws + WS_H2), (const bf16_t*)(a->ws + WS_WGU), nullptr, nullptr, M, 2 * DFF, DM}; pg8::StaticOrder S; S.init(M, 2 * DFF, F.G, (int)blockIdx.x);
        pg8::EpiSwiGLU E{(bf16_t*)(a->ws + WS_ACT), (const float*)(a->ws + WS_SS)};
        pg8::gemm_phase<pg8::EpiSwiGLU, pg8::StaticOrder>(F.lds, g, S, E);
        { const int rem = S.nwg % F.G, c = (int)blockIdx.x;
          if (rem == 0) tr_convert(F, a, TR_C, TR_D, c * NWAVES + F.wave, F.G * NWAVES);
          else if (c >= rem) tr_convert(F, a, TR_C, TR_D, (c - rem) * NWAVES + F.wave, (F.G - rem) * NWAVES); }
    } SEAM(9);

    if (IN(10)) { a = get_args();
        { pg8::Gemm g{(const bf16_t*)(a->ws + WS_ACT), (const bf16_t*)(a->ws + WS_WD), nullptr, nullptr, M, DM, DFF}; pg8::StaticOrder S; S.init(M, DM, F.G, (int)blockIdx.x);
          pg8::EpiResidNorm<true> E{(const bf16_t*)(a->ws + WS_H2), (bf16_t*)(a->ws + WS_H2), (float*)(a->ws + WS_SS) + M};
          pg8::gemm_phase<pg8::EpiResidNorm<true>, pg8::StaticOrder>(F.lds, g, S, E); }
        { pg8::Gemm g{(const bf16_t*)(a->ws + WS_PBF), (const bf16_t*)(a->ws + WS_WPLET), nullptr, nullptr, M, DM, PLE}; pg8::StaticOrder S; S.init(M, DM, F.G, (int)blockIdx.x);
          pg8::EpiBf16 E{(bf16_t*)(a->ws + WS_E), DM, 0, 0};
          pg8::gemm_phase<pg8::EpiBf16, pg8::StaticOrder>(F.lds, g, S, E); }
    } SEAM(10);

    if (IN(12)) { a = get_args();
        pg8::Gemm g{(const bf16_t*)(a->ws + WS_H2), (const bf16_t*)(a->ws + WS_WPG), nullptr, nullptr, M, DM, DM}; pg8::StaticOrder S; S.init(M, DM, F.G, (int)blockIdx.x);
        pg8::EpiPle E{(const bf16_t*)(a->ws + WS_E), (const bf16_t*)(a->ws + WS_H2), OUT, (const float*)(a->ws + WS_SS) + M};
        pg8::gemm_phase<pg8::EpiPle, pg8::StaticOrder>(F.lds, g, S, E);
    }
#undef IN
#undef SEAM
#undef X
#undef OUT
#undef RA
#undef RB
#undef RC
#undef RD
#undef RG
#undef KVA
}

extern "C" void kernel_launch(void* const* d_in, const int* in_sizes, int n_in, void* d_out, int out_size, void* d_ws, size_t ws_size, hipStream_t stream) {
    static int grid = 0;
    if (grid == 0) {
        if (n_in != 25 || in_sizes[0] != M * DM || out_size != M * DM || ws_size < WS_END) {
            fprintf(stderr, "kernel_launch: shape / workspace mismatch (n_in %d, in0 %d, out %d, ws %zu, need %zu); nothing launched\n", n_in, n_in > 0 ? in_sizes[0] : -1, out_size, ws_size, (size_t)WS_END); grid = -1; return; }
        int dev = 0, cus = 0, per_cu = 0;
        if (hipGetDevice(&dev) != hipSuccess || hipDeviceGetAttribute(&cus, hipDeviceAttributeMultiprocessorCount, dev) != hipSuccess) { grid = -1; return; }
        if (hipFuncSetAttribute((const void*)mk_fwd, hipFuncAttributeMaxDynamicSharedMemorySize, LDS_BYTES) != hipSuccess) { fprintf(stderr, "kernel_launch: hipFuncSetAttribute failed\n"); grid = -1; return; }
        if (hipOccupancyMaxActiveBlocksPerMultiprocessor(&per_cu, (const void*)mk_fwd, NWAVES * 64, LDS_BYTES) != hipSuccess || per_cu < 1)
            fprintf(stderr, "kernel_launch: occupancy query reports %d workgroups per CU\n", per_cu);
        (void)hipGetLastError();
        grid = cus;
        if (grid != 256) fprintf(stderr, "kernel_launch: %d CUs (built for 256)\n", grid);
    }
    if (grid < 0) return;
    if (hipMemsetAsync((char*)d_ws + WS_CTL, 0, CTL_ZERO_BYTES, stream) != hipSuccess) return;
    Args a{};
    for (int i = 0; i < 25; ++i) a.in[i] = d_in[i];
    a.out = (float*)d_out; a.ws = (unsigned char*)d_ws;
    if (MK_N_LAUNCHES == 1) { a.ph_lo = 0; a.ph_hi = NPH; hipLaunchKernelGGL(mk_fwd, dim3(grid), dim3(NWAVES * 64), LDS_BYTES, stream, a); }
    else for (int li = 0; li < NPH; ++li) { a.ph_lo = li; a.ph_hi = li + 1; hipLaunchKernelGGL(mk_fwd, dim3(grid), dim3(NWAVES * 64), LDS_BYTES, stream, a);
        if (MK_CHECK && li == 1) { a.ph_lo = 100; a.ph_hi = 101; hipLaunchKernelGGL(mk_fwd, dim3(grid), dim3(NWAVES * 64), LDS_BYTES, stream, a); } }
}
```
